# Optimizing an MI355X kernel written in HIP

```python
import jax, jax.numpy as jnp
from jax import lax
import numpy as np

D_MODEL = 1024
BATCH = 16
SEQ = 256
DEPTH = 4
DEC_BATCH = 4
DEC_SEQ = 4096
PAST_LEN = 256

GRID_W = 64
D_FF = ((8 * D_MODEL // 3 + 255) // 256) * 256
FFN_RESIDUAL = 0.5
N_MOD = 9
A_WIDTH = D_MODEL // 2
POOL_WINDOWS = (2, 4, 8, 16)
POOL_GROUP = A_WIDTH // len(POOL_WINDOWS)
NB_HEAD_DIM = 64
NB_HEADS = (D_MODEL // 2) // NB_HEAD_DIM
NB_ROWS = 8
NB_COLS = 16
C_HEAD_DIM = 64
C_Q_HEADS = D_MODEL // C_HEAD_DIM
C_KV_HEADS = C_Q_HEADS // 4
Q_BLOCK = 128
ROPE_THETA = 10000.0
EPS = 1e-6
NEG_INF = -1e30

kernel_name = "hybrid_dit_pool_natten_gqa_step"


def rms_norm(x, g):
    x32 = x.astype(jnp.float32)
    y = x32 * lax.rsqrt(jnp.mean(x32 * x32, axis=-1, keepdims=True) + EPS)
    return (y * g.astype(jnp.float32)).astype(x.dtype)


def modulate(h, shift, scale):
    return h * (1 + scale) + shift


def ada(cvec, w_mod, b_mod):
    m = jax.nn.silu(cvec) @ w_mod + b_mod
    if m.ndim == 2:
        m = m[:, None, :]
    return jnp.split(m, N_MOD, axis=-1)


def ffn_sub(x, g, shift, scale, gate, w_in, w_out):
    h = modulate(rms_norm(x, g), shift, scale)
    a, b = jnp.split(h @ w_in, 2, axis=-1)
    return x + gate * (FFN_RESIDUAL * ((jax.nn.silu(a) * b) @ w_out))


def head_rms(x, g):
    x32 = x.astype(jnp.float32)
    y = x32 * lax.rsqrt(jnp.mean(x32 * x32, axis=-1, keepdims=True) + EPS)
    return (y * g.astype(jnp.float32)).astype(x.dtype)


def _rotate(xa, pos):
    n = xa.shape[-1] // 2
    inv = ROPE_THETA ** (-jnp.arange(n, dtype=jnp.float32) / n)
    ang = pos[:, None] * inv[None, :]
    cos = jnp.cos(ang)[None, :, None, :]
    sin = jnp.sin(ang)[None, :, None, :]
    x1, x2 = xa[..., :n], xa[..., n:]
    return jnp.concatenate([x1 * cos - x2 * sin, x2 * cos + x1 * sin], axis=-1)


def rope_2d(x):
    L, D = x.shape[1], x.shape[-1]
    t = jnp.arange(L)
    x32 = x.astype(jnp.float32)
    half = D // 2
    xr = _rotate(x32[..., :half], (t // GRID_W).astype(jnp.float32))
    xc = _rotate(x32[..., half:], (t % GRID_W).astype(jnp.float32))
    return jnp.concatenate([xr, xc], axis=-1).astype(x.dtype)


def blocked_attention(q, k, v):
    B, Sq, Hq, D = q.shape
    Hkv = k.shape[2]
    G = Hq // Hkv
    nblk = Sq // Q_BLOCK
    qb = (q * (D ** -0.5)).reshape(B, nblk, Q_BLOCK, Hkv, G, D)
    qb = jnp.moveaxis(qb, 1, 0)

    def blk(qi):
        s = jnp.einsum('bqhgd,bkhd->bhgqk', qi, k).astype(jnp.float32)
        p = jax.nn.softmax(s, axis=-1).astype(v.dtype)
        return jnp.einsum('bhgqk,bkhd->bqhgd', p, v)

    o = lax.map(blk, qb)
    return jnp.moveaxis(o, 0, 1).reshape(B, Sq, Hq, D)


def pool_mix(u, w_pool, pool_scale):
    B, L, _ = u.shape
    u32 = u.astype(jnp.float32)
    t = jnp.arange(L)
    outs = []
    for gi, w in enumerate(POOL_WINDOWS):
        ug = u32[..., gi * POOL_GROUP:(gi + 1) * POOL_GROUP]
        csum = jnp.concatenate([jnp.zeros((B, 1, POOL_GROUP), jnp.float32), jnp.cumsum(ug, axis=1)], axis=1)
        lo = jnp.clip(t - w // 2, 0, L - 1)
        hi = jnp.clip(t + (w - 1 - w // 2), 0, L - 1)
        cnt = (hi - lo + 1).astype(jnp.float32)
        s = jnp.take(csum, hi + 1, axis=1) - jnp.take(csum, lo, axis=1)
        outs.append(s / cnt[None, :, None] - ug)
    pooled = jnp.stack(outs, axis=2).astype(u.dtype)
    mixed = jnp.einsum('blgc,gcd->blgd', pooled, w_pool).reshape(B, L, A_WIDTH)
    return mixed * pool_scale


def neighbourhood_attention(q, k, v, ctx_k, ctx_v, rpb):
    B, L, H, Dh = q.shape
    rows = L // GRID_W
    kh = min(NB_ROWS, rows)
    nb = kh * GRID_W
    qg = (q * (Dh ** -0.5)).reshape(B, rows, GRID_W, H, Dh)
    kg = k.reshape(B, rows, GRID_W, H, Dh)
    vg = v.reshape(B, rows, GRID_W, H, Dh)
    cq = jnp.arange(GRID_W)
    cstart = jnp.clip(cq - NB_COLS // 2, 0, GRID_W - NB_COLS)
    col_valid = (cq[None, :] >= cstart[:, None]) & (cq[None, :] < cstart[:, None] + NB_COLS)
    col_idx = jnp.clip(cq[None, :] - cq[:, None] + NB_COLS - 1, 0, 2 * NB_COLS - 2)

    def row_block(r):
        rs = jnp.clip(r - kh // 2, 0, rows - kh)
        kb = lax.dynamic_slice_in_dim(kg, rs, kh, axis=1)
        vb = lax.dynamic_slice_in_dim(vg, rs, kh, axis=1)
        qr = lax.dynamic_index_in_dim(qg, r, axis=1, keepdims=False)
        s_nb = jnp.einsum('bqhd,bkwhd->bhqkw', qr, kb).astype(jnp.float32)
        dr = rs + jnp.arange(kh) - r + NB_ROWS - 1
        bias = rpb[:, dr[:, None, None], col_idx[None, :, :]]
        bias = jnp.transpose(bias, (0, 2, 1, 3)).astype(jnp.float32)
        s_nb = jnp.where(col_valid[:, None, :], s_nb + bias, NEG_INF)
        s_ctx = jnp.einsum('bqhd,bchd->bhqc', qr, ctx_k).astype(jnp.float32)
        s = jnp.concatenate([s_nb.reshape(B, H, GRID_W, nb), s_ctx], axis=-1)
        p = jax.nn.softmax(s, axis=-1).astype(v.dtype)
        p_nb = p[..., :nb].reshape(B, H, GRID_W, kh, GRID_W)
        return (jnp.einsum('bhqkw,bkwhd->bqhd', p_nb, vb)
                + jnp.einsum('bhqc,bchd->bqhd', p[..., nb:], ctx_v))

    out = lax.map(row_block, jnp.arange(rows))
    return jnp.moveaxis(out, 0, 1).reshape(B, L, H, Dh)


def mixer_ab(h, w_in, w_pool, pool_scale, rpb, w_out, ctx_k=None, ctx_v=None):
    B, L, _ = h.shape
    proj = h @ w_in
    u = proj[..., :A_WIDTH]
    q, k, v = [t.reshape(B, L, NB_HEADS, NB_HEAD_DIM) for t in jnp.split(proj[..., A_WIDTH:], 3, axis=-1)]
    a_out = pool_mix(u, w_pool, pool_scale)
    if ctx_k is None:
        b_out = blocked_attention(q, k, v)
    else:
        b_out = neighbourhood_attention(q, k, v, ctx_k, ctx_v, rpb)
    out = jnp.concatenate([a_out, b_out.reshape(B, L, NB_HEADS * NB_HEAD_DIM)], axis=-1) @ w_out
    return out, k, v


def mixer_c(h, w_qkv, g_q, g_k, w_out, ctx_k=None, ctx_v=None):
    B, L, _ = h.shape
    proj = h @ w_qkv
    nq = C_Q_HEADS * C_HEAD_DIM
    nk = C_KV_HEADS * C_HEAD_DIM
    q = head_rms(proj[..., :nq].reshape(B, L, C_Q_HEADS, C_HEAD_DIM), g_q)
    k = head_rms(proj[..., nq:nq + nk].reshape(B, L, C_KV_HEADS, C_HEAD_DIM), g_k)
    v = proj[..., nq + nk:].reshape(B, L, C_KV_HEADS, C_HEAD_DIM)
    if ctx_k is None:
        o = blocked_attention(q, k, v)
    else:
        o = blocked_attention(rope_2d(q), jnp.concatenate([ctx_k, rope_2d(k)], axis=1),
                              jnp.concatenate([ctx_v, v], axis=1))
    return o.reshape(B, L, nq) @ w_out, k, v


def layer(p, l, x, cvec, ctx_k=None, ctx_v=None):
    sh1, sc1, g1, sh2, sc2, g2, sh3, sc3, g3 = ada(cvec, p['w_mod'][l], p['b_mod'][l])
    x = ffn_sub(x, p['g_norm'][l, 0], sh1, sc1, g1, p['w_ffn_in'][l, 0], p['w_ffn_out'][l, 0])
    h = modulate(rms_norm(x, p['g_norm'][l, 1]), sh2, sc2)
    if l % 2 == 0:
        e = l // 2
        mix, k, v = mixer_ab(h, p['w_in_ab'][e], p['w_pool'][e], p['pool_scale'][e], p['nb_rpb'][e],
                             p['w_out_ab'][e], ctx_k, ctx_v)
    else:
        o = l // 2
        mix, k, v = mixer_c(h, p['w_qkv_c'][o], p['g_qnorm'][o], p['g_knorm'][o], p['w_out_c'][o],
                            ctx_k, ctx_v)
    x = x + g2 * mix
    x = ffn_sub(x, p['g_norm'][l, 2], sh3, sc3, g3, p['w_ffn_in'][l, 1], p['w_ffn_out'][l, 1])
    return x, k, v


def setup_inputs(seed: int = 0) -> dict:
    key = jax.random.key(seed)
    ks = jax.random.split(key, 24)
    f32 = jnp.float32
    n_even = (DEPTH + 1) // 2
    n_odd = DEPTH // 2

    def nrm(k, shape, scale):
        return jax.random.normal(k, shape, f32) * scale

    mix_ab = A_WIDTH + NB_HEADS * NB_HEAD_DIM
    qkv_c = (C_Q_HEADS + 2 * C_KV_HEADS) * C_HEAD_DIM
    return {
        'x_prompt': nrm(ks[0], (BATCH, SEQ, D_MODEL), 1.0),
        'x_sample': nrm(ks[1], (DEC_BATCH, DEC_SEQ, D_MODEL), 1.0),
        'cache_nb_k': nrm(ks[2], (DEC_BATCH, n_even, PAST_LEN, NB_HEADS, NB_HEAD_DIM), 1.0),
        'cache_nb_v': nrm(ks[3], (DEC_BATCH, n_even, PAST_LEN, NB_HEADS, NB_HEAD_DIM), 1.0),
        'cache_attn_k': nrm(ks[4], (DEC_BATCH, n_odd, PAST_LEN, C_KV_HEADS, C_HEAD_DIM), 1.0),
        'cache_attn_v': nrm(ks[5], (DEC_BATCH, n_odd, PAST_LEN, C_KV_HEADS, C_HEAD_DIM), 1.0),
        'c': nrm(ks[6], (DEC_BATCH, D_MODEL), 1.0),
        'c_ctx': nrm(ks[7], (D_MODEL,), 1.0),
        'w_mod': nrm(ks[8], (DEPTH, D_MODEL, N_MOD * D_MODEL), 0.5 * D_MODEL ** -0.5),
        'b_mod': nrm(ks[9], (DEPTH, N_MOD * D_MODEL), 0.01),
        'g_norm': 1.0 + nrm(ks[10], (DEPTH, 3, D_MODEL), 0.1),
        'w_ffn_in': nrm(ks[11], (DEPTH, 2, D_MODEL, 2 * D_FF), D_MODEL ** -0.5),
        'w_ffn_out': nrm(ks[12], (DEPTH, 2, D_FF, D_MODEL), D_FF ** -0.5),
        'w_in_ab': nrm(ks[13], (n_even, D_MODEL, A_WIDTH + 3 * NB_HEADS * NB_HEAD_DIM), D_MODEL ** -0.5),
        'w_pool': nrm(ks[14], (n_even, len(POOL_WINDOWS), POOL_GROUP, POOL_GROUP), POOL_GROUP ** -0.5),
        'pool_scale': 1.0 + nrm(ks[15], (n_even, A_WIDTH), 0.1),
        'nb_rpb': nrm(ks[16], (n_even, NB_HEADS, 2 * NB_ROWS - 1, 2 * NB_COLS - 1), 0.1),
        'w_out_ab': nrm(ks[17], (n_even, mix_ab, D_MODEL), mix_ab ** -0.5),
        'w_qkv_c': nrm(ks[18], (n_odd, D_MODEL, qkv_c), D_MODEL ** -0.5),
        'g_qnorm': 1.0 + nrm(ks[19], (n_odd, C_HEAD_DIM), 0.1),
        'g_knorm': 1.0 + nrm(ks[20], (n_odd, C_HEAD_DIM), 0.1),
        'w_out_c': nrm(ks[21], (n_odd, C_Q_HEADS * C_HEAD_DIM, D_MODEL), (C_Q_HEADS * C_HEAD_DIM) ** -0.5),
        'g_final': 1.0 + nrm(ks[22], (D_MODEL,), 0.1),
    }


def reference(x_prompt, x_sample, cache_nb_k, cache_nb_v, cache_attn_k, cache_attn_v, c, c_ctx,
              w_mod, b_mod, g_norm, w_ffn_in, w_ffn_out, w_in_ab, w_pool, pool_scale, nb_rpb, w_out_ab,
              w_qkv_c, g_qnorm, g_knorm, w_out_c, g_final):
    p = {'w_mod': w_mod, 'b_mod': b_mod, 'g_norm': g_norm, 'w_ffn_in': w_ffn_in, 'w_ffn_out': w_ffn_out,
         'w_in_ab': w_in_ab, 'w_pool': w_pool, 'pool_scale': pool_scale, 'nb_rpb': nb_rpb,
         'w_out_ab': w_out_ab, 'w_qkv_c': w_qkv_c, 'g_qnorm': g_qnorm, 'g_knorm': g_knorm,
         'w_out_c': w_out_c}

    xp = x_prompt
    nb_k, nb_v, at_k, at_v = [], [], [], []
    for l in range(DEPTH):
        xp, k, v = layer(p, l, xp, c_ctx)
        if l % 2 == 0:
            nb_k.append(k)
            nb_v.append(v)
        else:
            at_k.append(k)
            at_v.append(v)
    y_prompt = rms_norm(xp, g_final)

    xs = x_sample
    for l in range(DEPTH):
        if l % 2 == 0:
            ck, cv = cache_nb_k[:, l // 2], cache_nb_v[:, l // 2]
        else:
            ck, cv = cache_attn_k[:, l // 2], cache_attn_v[:, l // 2]
        xs, _, _ = layer(p, l, xs, c, ck, cv)
    y_sample = rms_norm(xs, g_final)

    new_nb_k = jnp.stack(nb_k, axis=1)
    new_nb_v = jnp.stack(nb_v, axis=1)
    new_attn_k = jnp.stack(at_k, axis=1)
    new_attn_v = jnp.stack(at_v, axis=1)
    return (y_prompt, y_sample, new_nb_k, new_nb_v, new_attn_k, new_attn_v)
```

```cpp
#include <hip/hip_runtime.h>
#include <hip/hip_cooperative_groups.h>
#include <hip/hip_bf16.h>
#include <cstdio>
#include <cstdint>
#include <cmath>
namespace cg = cooperative_groups;
constexpr int NWAVES = 8;
constexpr int T = 20480, TC = 4096, D = 1024, DFF = 2816, NFF = 5632;
constexpr int FFO_KS = 1;
constexpr int OUT_KS = 1;
constexpr float EPS = 1e-6f;
constexpr size_t MiB = 1u << 20;
constexpr size_t WS_ROWSQ = 1 * MiB  , WS_MOD = 3 * MiB, WS_ROPE = 4 * MiB,
                 WS_WFI = 16 * MiB, WS_WFO = 104 * MiB, WS_WIAB = 148 * MiB, WS_WOAB = 156 * MiB, WS_WQKV = 160 * MiB, WS_WOC = 166 * MiB,
                 WS_X = 170 * MiB, WS_H = 250 * MiB, WS_A2 = 290 * MiB, WS_U = 330 * MiB, WS_CTXNB = 440 * MiB, WS_KCAT = 448 * MiB, WS_VCAT = 466 * MiB, WS_MODP = 484 * MiB, WS_PART = 496 * MiB  , WS_END = 560 * MiB;
constexpr size_t KCAT_STRIDE = 9 * MiB / 2;
constexpr int ADA_KC = 16;
constexpr int RING_OFF = 0, RING_BYTES = 131072, LDS_BYTES = 147456;
constexpr size_t WS_CTL = 0, CTL_ZERO_BYTES = 3u << 20; constexpr int CW_BAR = 4096, CW_CNT = 65536, CW_PCNT = 131072;
constexpr int LDSCTL_OFF = 131072, MISC_OFF = LDSCTL_OFF + 320;
__device__ __forceinline__ int tid_now() { int t = threadIdx.x; asm volatile("" : "+v"(t)); return t; }
__device__ __forceinline__ int sgpr_now(int v) { asm volatile("" : "+s"(v)); return v; }
namespace pg8 {
#define PG8_LAS __attribute__((address_space(3)))
typedef unsigned short bf16_t;
typedef short bf16x8 __attribute__((ext_vector_type(8)));
typedef float f32x4 __attribute__((ext_vector_type(4)));
typedef unsigned u32x4 __attribute__((ext_vector_type(4)));
typedef unsigned u32x2 __attribute__((ext_vector_type(2)));
typedef _Float16 h8 __attribute__((ext_vector_type(8)));
constexpr int BM = 256, BK = 64, HALF = 128, HTB = HALF * BK * 2  , STAGE_BYTES = 8 * HTB, NXCD = 8, WGM = 8;

__host__ __device__ __forceinline__ int lds_byte(int r, int c) { const int st = (r >> 4) * 2 + (c >> 5), rr = r & 15, cc = c & 31, ob = rr * 64 + cc * 2; return st * 1024 + (ob ^ (((ob >> 9) & 1) << 5)); }
__host__ __device__ __forceinline__ void stage_rc(int b, int& R, int& C) { const int st = b / 1024, sb = b % 1024, swz = sb ^ (((sb >> 9) & 1) << 5); R = (st >> 1) * 16 + swz / 64; C = (st & 1) * 32 + (swz % 64) / 2; }
__host__ __device__ __forceinline__ int perm32(int rho) { const int n = rho >> 4, i = rho & 15; return 8 * (i >> 2) + 4 * n + (i & 3); }

struct Unit { int pm, pn, k0, nk, slot, ks; };
struct Gemm { const bf16_t* A; const bf16_t* Bt; int M, N, K; };

struct StaticOrder {
    int nM, nN, nwg, G, c, ntf;
    __host__ __device__ void init(int M, int N, int K, int G_, int c_) { nM = M / BM; nN = N / BM; nwg = nM * nN; G = G_; c = c_; ntf = K / BK; }
    __host__ __device__ bool next(int i, Unit& u) const {
        const long L = (long)i * G + c; if (L >= nwg) return false;
        int wgid = (int)L; { const int q = nwg / NXCD, r = nwg % NXCD, xcd = wgid % NXCD, off = wgid / NXCD; wgid = (xcd < r ? xcd * (q + 1) : r * (q + 1) + (xcd - r) * q) + off; }
        const int nig = WGM * nN, gid = wgid / nig, fm = gid * WGM, gsz = (nM - fm) < WGM ? (nM - fm) : WGM;
        u.pm = fm + ((wgid % nig) % gsz); u.pn = (wgid % nig) / gsz; u.k0 = 0; u.nk = ntf; u.slot = 0; u.ks = 0; return true;
    }
    __device__ __forceinline__ void a_ready(const Unit&) const {}
    __device__ __forceinline__ void done(const Unit&) const {}
};

__device__ __forceinline__ unsigned cvt_pk_bf16(float lo, float hi) { unsigned r; asm volatile("v_cvt_pk_bf16_f32 %0, %1, %2" : "=v"(r) : "v"(lo), "v"(hi)); return r; }
__device__ __forceinline__ int ms_of_pm(int pm) { return pm < 16 ? 0 : 1 + ((pm - 16) >> 4); }
__device__ __forceinline__ float silu_f(float a) { return a * __builtin_amdgcn_rcpf(1.0f + __builtin_amdgcn_exp2f(-1.4426950408889634f * a)); }

struct EpiSwiGLU {
    static constexpr bool PERM = true, AFTER_DRAIN = false;
    bf16_t* U; int ldu; int ksplit; size_t split_stride;
    __device__ __forceinline__ void operator()(const f32x4 (&acc)[2][2][4][2], const Unit& u, int wr, int wc, int fr, int fq) const {
        const int row0 = u.pm * BM + wr * 64 + fr; int colt = u.pn * HALF; bf16_t* base = U;
        { const int t = colt / ksplit; base += (size_t)t * split_stride; colt -= t * ksplit; }
        const int col0 = colt + wc * 32 + 8 * fq;
#pragma unroll
        for (int ai = 0; ai < 2; ++ai)
#pragma unroll
            for (int m = 0; m < 4; ++m) { bf16_t* rowp = base + (size_t)(row0 + ai * HALF + m * 16) * ldu + col0;
                const f32x4 a0 = acc[ai][0][m][0], a1 = acc[ai][0][m][1], b0 = acc[ai][1][m][0], b1 = acc[ai][1][m][1];
                u32x4 w; w.x = cvt_pk_bf16(silu_f(a0[0]) * b0[0], silu_f(a0[1]) * b0[1]); w.y = cvt_pk_bf16(silu_f(a0[2]) * b0[2], silu_f(a0[3]) * b0[3]);
                w.z = cvt_pk_bf16(silu_f(a1[0]) * b1[0], silu_f(a1[1]) * b1[1]); w.w = cvt_pk_bf16(silu_f(a1[2]) * b1[2], silu_f(a1[3]) * b1[3]);
                *(u32x4*)rowp = w; }
    }
};
struct EpiResid {
    static constexpr bool PERM = true, AFTER_DRAIN = false;
    unsigned char* ws; const float* gnorm; float* yout; float scale; int ntf, ls, fused;
    __device__ __forceinline__ void operator()(f32x4 (&acc)[2][2][4][2], const Unit& u, int wr, int wc, int fr, int fq) const {
        const int tid = threadIdx.x;
        const int lyr = ls / 3, sub = ls - 3 * lyr, ln = (ls + 1) / 3, subn = (ls + 1) - 3 * ln;
        const float* const gate = (const float*)(ws + WS_MOD) + (size_t)lyr * 5 * 9216 + (3 * sub + 2) * 1024;
        float* const part = (float*)(ws + WS_PART); unsigned* const cnt = (unsigned*)(ws + WS_CTL) + CW_CNT + ls * 1024;
        bf16_t* const Hn = fused ? (bf16_t*)(ws + WS_H) : nullptr; const float* const gn = (fused == 2) ? gnorm : gnorm + (ls + 1) * 1024;
        const float* const modn = (const float*)(ws + WS_MOD) + (size_t)ln * 5 * 9216 + 3 * subn * 1024;
        float* const rsq = (float*)(ws + WS_ROWSQ) + (size_t)(ls + 1) * T; unsigned* const pcnt = (unsigned*)(ws + WS_CTL) + CW_PCNT + ls * 5120;
        __attribute__((address_space(3))) float* const S = (__attribute__((address_space(3))) float*)(LDSCTL_OFF + 2048);
        int lo = 0, hi = 8;
        const bool splitu = (u.nk != ntf);
        if (splitu) {
            const int own_ai = u.ks >> 1; const bool mine = (wr == (u.ks & 1));
            h8* P = (h8*)part + (size_t)(u.slot * 4 + u.ks) * (16 * 512) + tid;
#pragma unroll
            for (int j = 0; j < 16; ++j) if (!(mine && (j >> 3) == own_ai)) { const f32x4 a = acc[j >> 3][(j >> 2) & 1][j & 3][0], b = acc[j >> 3][(j >> 2) & 1][j & 3][1];
                const h8 v = {(_Float16)a[0], (_Float16)a[1], (_Float16)a[2], (_Float16)a[3], (_Float16)b[0], (_Float16)b[1], (_Float16)b[2], (_Float16)b[3]};
                asm volatile("global_store_dwordx4 %0, %1, off sc1\n\ts_nop 1" :: "v"(P + (size_t)j * 512), "v"(v) : "memory"); }
            asm volatile("s_waitcnt vmcnt(0)" ::: "memory");
            __syncthreads();
            if (tid == 0) { unsigned* c = cnt + 16 * u.slot; __hip_atomic_fetch_add(c, 1u, __ATOMIC_RELAXED, __HIP_MEMORY_SCOPE_AGENT);
                unsigned sp = 0; while (__hip_atomic_load(c, __ATOMIC_RELAXED, __HIP_MEMORY_SCOPE_AGENT) < 4u) { __builtin_amdgcn_s_sleep(1); if (++sp > (1u << 22)) break; } }
            __syncthreads();
            if (mine) {
#pragma unroll 1
                for (int kk = 1; kk < 4; ++kk) { const int k = (u.ks + kk) & 3; const h8* Q = (const h8*)part + (size_t)(u.slot * 4 + k) * (16 * 512) + tid;
#pragma unroll
                    for (int h = 0; h < 2; ++h) if (h == own_ai) { h8 t[8];
#pragma unroll
                        for (int j = 0; j < 8; ++j) asm volatile("global_load_dwordx4 %0, %1, off sc1" : "=v"(t[j]) : "v"(Q + (size_t)(h * 8 + j) * 512) : "memory");
                        asm volatile("s_waitcnt vmcnt(0)" : "+v"(t[0]), "+v"(t[1]), "+v"(t[2]), "+v"(t[3]), "+v"(t[4]), "+v"(t[5]), "+v"(t[6]), "+v"(t[7]) :: "memory");
#pragma unroll
                        for (int j = 0; j < 8; ++j) { const h8 v = t[j];
                            acc[h][(j >> 2) & 1][j & 3][0] += (f32x4){(float)v[0], (float)v[1], (float)v[2], (float)v[3]}; acc[h][(j >> 2) & 1][j & 3][1] += (f32x4){(float)v[4], (float)v[5], (float)v[6], (float)v[7]}; } } }
                lo = 4 * own_ai; hi = lo + 4;
            } else { lo = 0; hi = 0; }
        }
        const int pm = u.pm, pn = u.pn; const int ms = ms_of_pm(pm);
        const int col0 = pn * BM + wc * 32 + 8 * fq;
        {
            const float* g = gate + ms * 9216;
            f32x4 gv[2][2];
#pragma unroll
            for (int bj = 0; bj < 2; ++bj)
#pragma unroll
                for (int n = 0; n < 2; ++n) gv[bj][n] = *(const f32x4*)(g + col0 + bj * HALF + n * 4) * scale;
            const size_t off0 = (size_t)(pm * BM + wr * 64 + fr) * 1024 + col0;
            const _Float16* const Xh = (const _Float16*)(ws + WS_X);
#define PG8_FIN_ROWGROUP(H_, M_, B00, B01, B10, B11) do { float ss = 0.f; \
                { const f32x4 x = (B00) + gv[0][0] * acc[H_][0][M_][0]; acc[H_][0][M_][0] = x; ss += (x[0] * x[0] + x[1] * x[1]) + (x[2] * x[2] + x[3] * x[3]); } \
                { const f32x4 x = (B01) + gv[0][1] * acc[H_][0][M_][1]; acc[H_][0][M_][1] = x; ss += (x[0] * x[0] + x[1] * x[1]) + (x[2] * x[2] + x[3] * x[3]); } \
                { const f32x4 x = (B10) + gv[1][0] * acc[H_][1][M_][0]; acc[H_][1][M_][0] = x; ss += (x[0] * x[0] + x[1] * x[1]) + (x[2] * x[2] + x[3] * x[3]); } \
                { const f32x4 x = (B11) + gv[1][1] * acc[H_][1][M_][1]; acc[H_][1][M_][1] = x; ss += (x[0] * x[0] + x[1] * x[1]) + (x[2] * x[2] + x[3] * x[3]); } \
                if (Hn) { ss += __shfl_xor(ss, 16); ss += __shfl_xor(ss, 32); if (fq == 0) S[((H_) * HALF + wr * 64 + (M_) * 16 + fr) * 4 + wc] = ss; } } while (0)
            {
                h8 lh[8][2];
#pragma unroll
                for (int i = 0; i < 8; ++i) if (i >= lo && i < hi) {
#pragma unroll
                    for (int bj = 0; bj < 2; ++bj) lh[i][bj] = *(const h8*)(Xh + off0 + (size_t)((i >> 2) * HALF + (i & 3) * 16) * 1024 + bj * HALF); }
                asm volatile("" ::: "memory");
#pragma unroll
                for (int h = 0; h < 2; ++h)
#pragma unroll
                    for (int m = 0; m < 4; ++m) if (4 * h + m >= lo && 4 * h + m < hi) { const h8 v0 = lh[4 * h + m][0], v1 = lh[4 * h + m][1];
                        PG8_FIN_ROWGROUP(h, m, ((f32x4){(float)v0[0], (float)v0[1], (float)v0[2], (float)v0[3]}), ((f32x4){(float)v0[4], (float)v0[5], (float)v0[6], (float)v0[7]}),
                                               ((f32x4){(float)v1[0], (float)v1[1], (float)v1[2], (float)v1[3]}), ((f32x4){(float)v1[4], (float)v1[5], (float)v1[6], (float)v1[7]})); }
                asm volatile("" ::: "memory");
            }
#undef PG8_FIN_ROWGROUP
            if (fused != 2) {
                _Float16* const Xo = (_Float16*)(ws + WS_X);
#pragma unroll
                for (int h = 0; h < 2; ++h) {
                    size_t offh = off0 + (size_t)(h * HALF) * 1024; asm volatile("" : "+v"(offh));
#pragma unroll
                    for (int m = 0; m < 4; ++m) if (4 * h + m >= lo && 4 * h + m < hi) {
#pragma unroll
                        for (int bj = 0; bj < 2; ++bj) { const f32x4 a = acc[h][bj][m][0], b = acc[h][bj][m][1];
                            const h8 o = {(_Float16)a[0], (_Float16)a[1], (_Float16)a[2], (_Float16)a[3], (_Float16)b[0], (_Float16)b[1], (_Float16)b[2], (_Float16)b[3]};
                            *(h8*)(Xo + offh + (size_t)(m * 16) * 1024 + bj * HALF) = o; } }
                }
            }
        }
        if (!Hn) return;
        const int rb = splitu ? (u.ks >> 1) * HALF + (u.ks & 1) * 64 : 0, nr = splitu ? 64 : BM;
        __syncthreads();
        if (tid < nr) { const int rl = rb + tid; const float tot = (S[rl * 4 + 0] + S[rl * 4 + 1]) + (S[rl * 4 + 2] + S[rl * 4 + 3]); unsafeAtomicAdd(rsq + pm * BM + rl, tot); }
        asm volatile("s_waitcnt vmcnt(0)" ::: "memory");
        __syncthreads();
        if (tid == 0) { unsigned* c = pcnt + 16 * (pm * 4 + (splitu ? u.ks : 0)); __hip_atomic_fetch_add(c, 1u, __ATOMIC_RELAXED, __HIP_MEMORY_SCOPE_AGENT);
            unsigned sp = 0; while (__hip_atomic_load(c, __ATOMIC_RELAXED, __HIP_MEMORY_SCOPE_AGENT) < 4u) { __builtin_amdgcn_s_sleep(1); if (++sp > (1u << 22)) break; } }
        __syncthreads();
        if (hi == 0) return;
        float rr[8];
#pragma unroll
        for (int i = 0; i < 8; ++i) { rr[i] = 0.f; if (i >= lo && i < hi) { const float v = __hip_atomic_load(rsq + pm * BM + (i >> 2) * HALF + wr * 64 + (i & 3) * 16 + fr, __ATOMIC_RELAXED, __HIP_MEMORY_SCOPE_AGENT); rr[i] = __builtin_amdgcn_rsqf(v * (1.0f / 1024.0f) + 1e-6f); } }
        const float* shp = modn + ms * 9216 + col0; const float* gp = gn + col0;
#pragma unroll
        for (int bj = 0; bj < 2; ++bj) { const int co = bj * HALF;
            const size_t o0 = (size_t)(pm * BM + wr * 64 + fr) * 1024 + col0 + co;
            if (fused == 2) {
                const f32x4 gs0 = *(const f32x4*)(gp + co), gs1 = *(const f32x4*)(gp + co + 4);
#pragma unroll
                for (int i = 0; i < 8; ++i) if (i >= lo && i < hi) { float* yp = yout + o0 + (size_t)((i >> 2) * HALF + (i & 3) * 16) * 1024;
                    *(f32x4*)yp = (acc[i >> 2][bj][i & 3][0] * rr[i]) * gs0; *(f32x4*)(yp + 4) = (acc[i >> 2][bj][i & 3][1] * rr[i]) * gs1; }
            } else {
                const f32x4 gs0 = *(const f32x4*)(gp + co) * (*(const f32x4*)(shp + 1024 + co) + 1.0f), gs1 = *(const f32x4*)(gp + co + 4) * (*(const f32x4*)(shp + 1024 + co + 4) + 1.0f);
                const f32x4 sh0 = *(const f32x4*)(shp + co), sh1 = *(const f32x4*)(shp + co + 4);
#pragma unroll
                for (int i = 0; i < 8; ++i) if (i >= lo && i < hi) { const f32x4 y0 = (acc[i >> 2][bj][i & 3][0] * rr[i]) * gs0 + sh0, y1 = (acc[i >> 2][bj][i & 3][1] * rr[i]) * gs1 + sh1;
                    u32x4 w; w.x = cvt_pk_bf16(y0[0], y0[1]); w.y = cvt_pk_bf16(y0[2], y0[3]); w.z = cvt_pk_bf16(y1[0], y1[1]); w.w = cvt_pk_bf16(y1[2], y1[3]);
                    *(u32x4*)(Hn + o0 + (size_t)((i >> 2) * HALF + (i & 3) * 16) * 1024) = w; }
            } }
    }
};
struct EpiProj {
    static constexpr bool PERM = true, AFTER_DRAIN = false;
    bf16_t* O; int ldc; int sc_lo, sc_hi; float sc; float* fo[2]; int f_lo[2], f_hi[2]; int fw;
    __device__ __forceinline__ void operator()(const f32x4 (&acc)[2][2][4][2], const Unit& u, int wr, int wc, int fr, int fq) const {
        const int row0 = u.pm * BM + wr * 64 + fr; const int col0 = u.pn * BM + wc * 32 + 8 * fq;
        const float s = (u.pn >= sc_lo && u.pn < sc_hi) ? sc : 1.0f;
        float* fdst = nullptr;
        if (u.pm < 16) {
#pragma unroll
            for (int i = 0; i < 2; ++i) if (u.pn >= f_lo[i] && u.pn < f_hi[i]) fdst = fo[i] + (size_t)(u.pm * 512 + wr * 64 + fr) * fw + (col0 - 256 * f_lo[i]);
        }
#pragma unroll
        for (int ai = 0; ai < 2; ++ai)
#pragma unroll
            for (int m = 0; m < 4; ++m) { bf16_t* rowp = O + (size_t)(row0 + ai * HALF + m * 16) * ldc + col0;
#pragma unroll
                for (int bj = 0; bj < 2; ++bj) { const f32x4 v0 = acc[ai][bj][m][0] * s, v1 = acc[ai][bj][m][1] * s;
                    u32x4 w; w.x = cvt_pk_bf16(v0[0], v0[1]); w.y = cvt_pk_bf16(v0[2], v0[3]); w.z = cvt_pk_bf16(v1[0], v1[1]); w.w = cvt_pk_bf16(v1[2], v1[3]);
                    *(u32x4*)(rowp + bj * HALF) = w;
                    if (fdst) { float* fp = fdst + (size_t)(ai * HALF + m * 16) * fw + bj * HALF; *(f32x4*)fp = acc[ai][bj][m][0]; *(f32x4*)(fp + 4) = acc[ai][bj][m][1]; } } }
    }
};
struct EpiQKV {
    static constexpr bool PERM = true, AFTER_DRAIN = false;
    unsigned char* ws; const float* gq; const float* gk; float* okv; int e;
    __device__ __forceinline__ void operator()(const f32x4 (&acc)[2][2][4][2], const Unit& u, int wr_, int wc_, int fr_, int fq_) const {
        const int t_ = tid_now(), wid_ = t_ >> 6, wr = wid_ >> 2, wc = wid_ & 3, fr = t_ & 15, fq = (t_ & 63) >> 4; (void)wr_; (void)wc_; (void)fr_; (void)fq_;
        constexpr float c2 = 0.125f * 1.4426950408889634f;
        bf16_t* const O = (bf16_t*)(ws + WS_U); const float* const rope = (const float*)(ws + WS_ROPE);
        bf16_t* const Kc = (bf16_t*)(ws + WS_KCAT) + (size_t)e * KCAT_STRIDE; bf16_t* const Vc = (bf16_t*)(ws + WS_VCAT) + (size_t)e * KCAT_STRIDE;
        __attribute__((address_space(3))) float* const S2 = (__attribute__((address_space(3))) float*)(LDSCTL_OFF + 2048);
        const int pn = u.pn, pm = u.pm; const bool lat = pm >= 16, normed = pn <= 4;
        const int rl0 = wr * 64 + fr, dloc = (wc & 1) * 32 + 8 * fq;
        if (normed) {
#pragma unroll
            for (int ai = 0; ai < 2; ++ai)
#pragma unroll
                for (int m = 0; m < 4; ++m)
#pragma unroll
                    for (int bj = 0; bj < 2; ++bj) { const f32x4 x0 = acc[ai][bj][m][0], x1 = acc[ai][bj][m][1];
                        float ss = ((x0[0] * x0[0] + x0[1] * x0[1]) + (x0[2] * x0[2] + x0[3] * x0[3])) + ((x1[0] * x1[0] + x1[1] * x1[1]) + (x1[2] * x1[2] + x1[3] * x1[3]));
                        ss += __shfl_xor(ss, 16); ss += __shfl_xor(ss, 32);
                        if (fq == 0) S2[((ai * HALF + m * 16 + rl0) * 2 + bj) * 4 + wc] = ss; }
            __syncthreads();
        }
        f32x4 g0 = {1.f, 1.f, 1.f, 1.f}, g1 = g0;
        if (normed) { const float* gg = (pn < 4 ? gq : gk) + dloc; g0 = *(const f32x4*)gg; g1 = *(const f32x4*)(gg + 4); }
        const float sgn = (fq & 2) ? 1.0f : -1.0f, qs = (pn < 4) ? c2 : 1.0f;
#pragma unroll
        for (int ai = 0; ai < 2; ++ai)
#pragma unroll
            for (int m = 0; m < 4; ++m) {
                asm volatile("" ::: "memory");
                const int rl = ai * HALF + m * 16 + rl0; const int row = pm * BM + rl; const int tl = (row - 4096) & 4095, bb = (row - 4096) >> 12;
                f32x4 c0 = {1.f, 0.f, 1.f, 0.f}, c1 = c0, c2v = c0, c3 = c0;
                if (lat && normed) { const int pos = (wc & 1) ? (tl & 63) : (tl >> 6); const float* rp = rope + (pos * 16 + 8 * (fq & 1)) * 2;
                    c0 = *(const f32x4*)rp; c1 = *(const f32x4*)(rp + 4); c2v = *(const f32x4*)(rp + 8); c3 = *(const f32x4*)(rp + 12); }
#pragma unroll
                for (int bj = 0; bj < 2; ++bj) {
                    f32x4 x0 = acc[ai][bj][m][0], x1 = acc[ai][bj][m][1];
                    if (normed) {
                        const float ss = S2[(rl * 2 + bj) * 4 + wc] + S2[(rl * 2 + bj) * 4 + (wc ^ 1)]; const float r = __builtin_amdgcn_rsqf(ss * (1.0f / 64.0f) + 1e-6f);
                        x0 = x0 * r * g0; x1 = x1 * r * g1;
                        if (lat) { f32x4 p0, p1;
#pragma unroll
                            for (int t = 0; t < 4; ++t) { p0[t] = __shfl_xor(x0[t], 32); p1[t] = __shfl_xor(x1[t], 32); }
                            x0 = (f32x4){x0[0] * c0[0] + sgn * p0[0] * c0[1], x0[1] * c0[2] + sgn * p0[1] * c0[3], x0[2] * c1[0] + sgn * p0[2] * c1[1], x0[3] * c1[2] + sgn * p0[3] * c1[3]};
                            x1 = (f32x4){x1[0] * c2v[0] + sgn * p1[0] * c2v[1], x1[1] * c2v[2] + sgn * p1[1] * c2v[3], x1[2] * c3[0] + sgn * p1[2] * c3[1], x1[3] * c3[2] + sgn * p1[3] * c3[3]}; }
                    }
                    const f32x4 y0 = x0 * qs, y1 = x1 * qs;
                    u32x4 w; w.x = cvt_pk_bf16(y0[0], y0[1]); w.y = cvt_pk_bf16(y0[2], y0[3]); w.z = cvt_pk_bf16(y1[0], y1[1]); w.w = cvt_pk_bf16(y1[2], y1[3]);
                    const int hcol = (bj * 2 + (wc >> 1)) * 64 + dloc;
                    if (pn < 4 || !lat) *(u32x4*)(O + (size_t)row * 1536 + pn * BM + hcol) = w;
                    else *(u32x4*)((pn == 4 ? Kc : Vc) + ((size_t)bb * 4352 + 256 + tl) * 256 + hcol) = w;
                    if (pn >= 4 && !lat) { float* fp = okv + (pn == 5 ? 16 * 2 * 256 * 256 : 0) + ((size_t)(pm * 2) * 256 + rl) * 256 + hcol; *(f32x4*)fp = x0; *(f32x4*)(fp + 4) = x1; }
                }
            }
    }
};
struct TailOrder {
    int nM, nN, nwg, G, c, ntf; bool split;
    __host__ __device__ void init(int M, int N, int K, int G_, int c_) { nM = M / BM; nN = N / BM; nwg = nM * nN; G = G_; c = c_; ntf = K / BK; split = (G == 256 && nM == 80 && nN == 4 && ntf >= 16); }
    __host__ __device__ bool next(int i, Unit& u) const {
        if (split) {
            const int x = c & 7, j = c >> 3;
            if (i == 0) { u.pm = 8 * x + (j & 7); u.pn = j >> 3; u.k0 = 0; u.nk = ntf; u.slot = 0; u.ks = 0; return true; }
            if (i == 1) { const int t8 = j >> 2, q = j & 3; u.pm = 64 + 2 * x + (t8 >> 2); u.pn = t8 & 3;
                const int pairs = ntf >> 1, pq = pairs >> 2, rem = pairs & 3; u.k0 = 2 * (q * pq + (q < rem ? q : rem)); u.nk = 2 * (pq + (q < rem ? 1 : 0)); u.slot = x * 8 + t8; u.ks = q; return true; }
            return false;
        }
        const long L = (long)i * G + c; if (L >= nwg) return false;
        int wgid = (int)L; { const int qq = nwg / NXCD, r = nwg % NXCD, xcd = wgid % NXCD, off = wgid / NXCD; wgid = (xcd < r ? xcd * (qq + 1) : r * (qq + 1) + (xcd - r) * qq) + off; }
        const int nig = WGM * nN, gid = wgid / nig, fm = gid * WGM, gsz = (nM - fm) < WGM ? (nM - fm) : WGM;
        u.pm = fm + ((wgid % nig) % gsz); u.pn = (wgid % nig) / gsz; u.k0 = 0; u.nk = ntf; u.slot = 0; u.ks = 0;
        return true;
    }
    __device__ __forceinline__ void a_ready(const Unit&) const {}
    __device__ __forceinline__ void done(const Unit&) const {}
};

template <class Epi, class Sched, bool ALIGN_EPI = false, bool SP2 = false>
__device__ __forceinline__ void gemm_phase(PG8_LAS unsigned char* lds, const Gemm g, const Sched& S, const Epi& E) {
    const int tid = tid_now(), wid = __builtin_amdgcn_readfirstlane(tid >> 6), lane = tid & 63, wr = wid >> 2, wc = wid & 3, fr = lane & 15, fq = lane >> 4;
    const int K = g.K;
    unsigned voffA[2], voffB[2];
#pragma unroll
    for (int i = 0; i < 2; ++i) { int R, C; stage_rc(tid * 16 + i * 8192, R, C); const int Rb = Epi::PERM ? ((R & ~31) + perm32(R & 31)) : R;
        voffA[i] = (unsigned)(R * K + C) * 2u; voffB[i] = (unsigned)(Rb * K + C) * 2u; }
    const size_t kstep = (size_t)(BK * 2);
    const size_t hstep = (size_t)HALF * K * 2;
    const size_t tstep = 2 * hstep;
    const unsigned ldsw = (unsigned)wid * 1024u;
    const int aoff = lds_byte(wr * 64 + fr, fq * 8), boff = lds_byte(wc * 32 + fr, fq * 8);
#define PG8_SA(b, h) (((b) * 2 + (h)) * HTB)
#define PG8_SB(b, h) ((4 + (b) * 2 + (h)) * HTB)
#define PG8_STAGE(bufoff, gbase, voff) do { _Pragma("unroll") for (int _i = 0; _i < 2; ++_i) \
        __builtin_amdgcn_global_load_lds((const unsigned*)((const char*)(gbase) + (voff)[_i]), (PG8_LAS unsigned*)(lds + (bufoff) + ldsw + _i * 8192), 16, 0, 0); } while (0)
#define PG8_LDA(dst, b, h) do { _Pragma("unroll") for (int m = 0; m < 4; ++m) _Pragma("unroll") for (int k = 0; k < 2; ++k) dst[m][k] = *(const PG8_LAS bf16x8*)(lds + PG8_SA(b, h) + aoff + m * 2048 + k * 1024); } while (0)
#define PG8_LDB(dst, b, h) do { _Pragma("unroll") for (int n = 0; n < 2; ++n) _Pragma("unroll") for (int k = 0; k < 2; ++k) dst[n][k] = *(const PG8_LAS bf16x8*)(lds + PG8_SB(b, h) + boff + n * 2048 + k * 1024); } while (0)
#define PG8_MMA(ai, bj, At, Bt) do { __builtin_amdgcn_s_setprio(1); _Pragma("unroll") for (int m = 0; m < 4; ++m) _Pragma("unroll") for (int n = 0; n < 2; ++n) _Pragma("unroll") for (int k = 0; k < 2; ++k) \
        acc[ai][bj][m][n] = __builtin_amdgcn_mfma_f32_16x16x32_bf16(Bt[n][k], At[m][k], acc[ai][bj][m][n], 0, 0, 0); __builtin_amdgcn_s_setprio(0); } while (0)
#define PG8_WAIT_V(n) asm volatile("s_waitcnt vmcnt(" #n ")" ::: "memory")
#define PG8_WAIT_L(n) asm volatile("s_waitcnt lgkmcnt(" #n ")" ::: "memory")
#define PG8_BAR __builtin_amdgcn_s_barrier()
#define PG8_SCHED __builtin_amdgcn_sched_barrier(0)
    Unit cur, nxt; int ui = 0;
    if (!S.next(0, cur)) return;
    f32x4 acc[2][2][4][2];
#pragma unroll
    for (int a = 0; a < 2; ++a)
#pragma unroll
        for (int b = 0; b < 2; ++b)
#pragma unroll
            for (int m = 0; m < 4; ++m)
#pragma unroll
                for (int n = 0; n < 2; ++n) acc[a][b][m][n] = (f32x4){0.f, 0.f, 0.f, 0.f};
    bf16x8 At[4][2], B0[2][2], B1[2][2];
    const char* cA = (const char*)g.A + (size_t)cur.pm * tstep + (size_t)cur.k0 * kstep; const char* cB = (const char*)g.Bt + (size_t)cur.pn * tstep + (size_t)cur.k0 * kstep;
    S.a_ready(cur);
    if constexpr (SP2) {
        PG8_STAGE(PG8_SB(0, 0), cB, voffB); PG8_STAGE(PG8_SB(0, 1), cB + hstep, voffB); PG8_STAGE(PG8_SA(0, 0), cA, voffA); PG8_STAGE(PG8_SA(0, 1), cA + hstep, voffA);
        if (wr == 1) PG8_BAR;
        PG8_WAIT_V(2); PG8_BAR;
        PG8_STAGE(PG8_SB(1, 0), cB + kstep, voffB); PG8_STAGE(PG8_SA(1, 0), cA + kstep, voffA); PG8_STAGE(PG8_SB(1, 1), cB + hstep + kstep, voffB);
        PG8_WAIT_V(6); PG8_BAR;
    } else {
        PG8_STAGE(PG8_SB(0, 0), cB, voffB); PG8_STAGE(PG8_SA(0, 0), cA, voffA); PG8_STAGE(PG8_SB(0, 1), cB + hstep, voffB); PG8_STAGE(PG8_SA(0, 1), cA + hstep, voffA);
        if (wr == 1) PG8_BAR;
        PG8_WAIT_V(4); PG8_BAR;
        PG8_STAGE(PG8_SB(1, 0), cB + kstep, voffB); PG8_STAGE(PG8_SA(1, 0), cA + kstep, voffA); PG8_STAGE(PG8_SB(1, 1), cB + hstep + kstep, voffB);
        PG8_WAIT_V(6); PG8_BAR;
    }
    for (;;) {
        const bool has_next = S.next(ui + 1, nxt);
        const char* nA = has_next ? (const char*)g.A + (size_t)nxt.pm * tstep + (size_t)nxt.k0 * kstep : cA; const char* nB = has_next ? (const char*)g.Bt + (size_t)nxt.pn * tstep + (size_t)nxt.k0 * kstep : cB;
        const int nt = cur.nk;
        for (int t = 0; t < nt; t += 2) {
            const bool last = (t == nt - 2);
            const char* a1 = cA + (size_t)(t + 1) * kstep;
            const char* a2 = last ? nA : cA + (size_t)(t + 2) * kstep; const char* b2 = last ? nB : cB + (size_t)(t + 2) * kstep;
            const char* a3 = a2 + kstep; const char* b3 = b2 + kstep;
            if (last && has_next) S.a_ready(nxt);
            if constexpr (SP2) {
            PG8_LDB(B0, 0, 0); PG8_LDB(B1, 0, 1); PG8_SCHED; PG8_LDA(At, 0, 0); PG8_STAGE(PG8_SA(1, 1), a1 + hstep, voffA);
            PG8_WAIT_V(8); PG8_WAIT_L(0); PG8_BAR; PG8_MMA(0, 0, At, B0); PG8_MMA(0, 1, At, B1); PG8_BAR; PG8_SCHED;
            PG8_LDA(At, 0, 1); PG8_STAGE(PG8_SB(0, 0), b2, voffB); PG8_STAGE(PG8_SB(0, 1), b2 + hstep, voffB); PG8_STAGE(PG8_SA(0, 0), a2, voffA);
            PG8_WAIT_V(8); PG8_WAIT_L(0); PG8_BAR; PG8_MMA(1, 0, At, B0); PG8_MMA(1, 1, At, B1); PG8_BAR; PG8_SCHED;
            PG8_LDB(B0, 1, 0); PG8_LDB(B1, 1, 1); PG8_SCHED; PG8_LDA(At, 1, 0); PG8_STAGE(PG8_SA(0, 1), a2 + hstep, voffA);
            PG8_WAIT_V(8); PG8_WAIT_L(0); PG8_BAR; PG8_MMA(0, 0, At, B0); PG8_MMA(0, 1, At, B1); PG8_BAR; PG8_SCHED;
            PG8_LDA(At, 1, 1); PG8_STAGE(PG8_SB(1, 0), b3, voffB); PG8_STAGE(PG8_SB(1, 1), b3 + hstep, voffB); PG8_STAGE(PG8_SA(1, 0), a3, voffA);
            PG8_WAIT_V(8); PG8_WAIT_L(0); PG8_BAR; PG8_MMA(1, 0, At, B0); PG8_MMA(1, 1, At, B1); PG8_BAR; PG8_SCHED;
            } else {
            PG8_LDB(B0, 0, 0); PG8_SCHED; PG8_LDA(At, 0, 0); PG8_STAGE(PG8_SA(1, 1), a1 + hstep, voffA);
            PG8_WAIT_L(8); PG8_BAR; PG8_WAIT_L(0); PG8_MMA(0, 0, At, B0); PG8_BAR; PG8_SCHED;
            PG8_LDB(B1, 0, 1); PG8_STAGE(PG8_SB(0, 0), b2, voffB);
            PG8_BAR; PG8_WAIT_L(0); PG8_MMA(0, 1, At, B1); PG8_BAR;
            PG8_LDA(At, 0, 1); PG8_STAGE(PG8_SA(0, 0), a2, voffA);
            PG8_BAR; PG8_WAIT_L(0); PG8_MMA(1, 0, At, B0); PG8_BAR; PG8_SCHED;
            PG8_STAGE(PG8_SB(0, 1), b2 + hstep, voffB);
            PG8_WAIT_V(6); PG8_BAR; PG8_MMA(1, 1, At, B1); PG8_BAR;
            PG8_LDB(B0, 1, 0); PG8_SCHED; PG8_LDA(At, 1, 0); PG8_STAGE(PG8_SA(0, 1), a2 + hstep, voffA);
            PG8_WAIT_L(8); PG8_BAR; PG8_WAIT_L(0); PG8_MMA(0, 0, At, B0); PG8_BAR; PG8_SCHED;
            PG8_LDB(B1, 1, 1); PG8_STAGE(PG8_SB(1, 0), b3, voffB);
            PG8_BAR; PG8_WAIT_L(0); PG8_MMA(0, 1, At, B1); PG8_BAR;
            PG8_LDA(At, 1, 1); PG8_STAGE(PG8_SA(1, 0), a3, voffA);
            PG8_BAR; PG8_WAIT_L(0); PG8_MMA(1, 0, At, B0); PG8_BAR; PG8_SCHED;
            PG8_STAGE(PG8_SB(1, 1), b3 + hstep, voffB);
            PG8_WAIT_V(6); PG8_BAR; PG8_MMA(1, 1, At, B1); PG8_BAR;
            }
        }
        if constexpr (ALIGN_EPI) { if (wr == 0) PG8_BAR; }
        if constexpr (!Epi::AFTER_DRAIN) { E(acc, cur, wr, wc, fr, fq); S.done(cur); }
        if (!has_next) break;
#pragma unroll
        for (int a = 0; a < 2; ++a)
#pragma unroll
            for (int b = 0; b < 2; ++b)
#pragma unroll
                for (int m = 0; m < 4; ++m)
#pragma unroll
                    for (int n = 0; n < 2; ++n) acc[a][b][m][n] = (f32x4){0.f, 0.f, 0.f, 0.f};
        cur = nxt; cA = nA; cB = nB; ++ui;
        if constexpr (ALIGN_EPI) { if (wr == 1) PG8_BAR; }
    }
    PG8_WAIT_V(0);
    if constexpr (!ALIGN_EPI) { if (wr == 0) PG8_BAR; }
    PG8_BAR;
    if constexpr (Epi::AFTER_DRAIN) { E.fused(acc, cur, wr, wc, fr, fq, lds, wid, lane); S.done(cur); }
#undef PG8_SA
#undef PG8_SB
#undef PG8_STAGE
#undef PG8_LDA
#undef PG8_LDB
#undef PG8_MMA
#undef PG8_WAIT_V
#undef PG8_WAIT_L
#undef PG8_BAR
#undef PG8_SCHED
}
}
namespace attn_body {
using bf16=__hip_bfloat16;
using bf16x8=__attribute__((ext_vector_type(8)))short;
using s16x4=__attribute__((ext_vector_type(4)))short;
using f32x16=__attribute__((ext_vector_type(16)))float;
using u32x4=__attribute__((ext_vector_type(4)))unsigned;
constexpr int D=64;
constexpr int NW=8,QBLK=32,QB=QBLK*NW,KVBLK=64;
constexpr int ATTN_UNIT_ROWS=QB;
__device__ __forceinline__ int crow(int r,int hi){return (r&3)+8*(r>>2)+4*hi;}
#define SBAR() __builtin_amdgcn_sched_barrier(0)
typedef const __attribute__((address_space(3))) float* lds_cfptr;
__device__ __forceinline__ void nmask(f32x16&p0,f32x16&p1,int kr,int qr,int qc,int hi,lds_cfptr tab){
  const float NEG=-1e30f; int rs=qr-4; rs=rs<0?0:rs; rs=rs>56?56:rs; const int dr=kr-rs;
  if(dr<0||dr>=8){
    #pragma unroll
    for(int r=0;r<16;++r){p0[r]=NEG;p1[r]=NEG;}
    return; }
  int cs=qc-8; cs=cs<0?0:cs; cs=cs>48?48:cs;
  lds_cfptr trow=tab+((kr-qr+7)*31+15-qc);
  #pragma unroll
  for(int r=0;r<16;++r){ const int kc=(r&3)+8*(r>>2)+4*hi;
    const float b0=trow[kc], b1=trow[kc+32];
    p0[r]=((unsigned)(kc-cs)<16u)?p0[r]+b0:NEG; p1[r]=((unsigned)(kc+32-cs)<16u)?p1[r]+b1:NEG; }
}

constexpr int NSLOT=3, SLOTB=8192;
constexpr int LDS_K=0, LDS_V=NSLOT*SLOTB, LDS_WS=2*NSLOT*SLOTB, LDS_OST=LDS_WS+NW*64*4, LDS_BYTES=LDS_OST+NW*4096;
constexpr float C2=0.125f*1.4426950408889634f;
__device__ __forceinline__ void glds16(const void*gsrc,unsigned lds_dst){unsigned keep;
  asm volatile("s_mov_b32 %0, m0\n\ts_mov_b32 m0, %2\n\ts_nop 0\n\tglobal_load_lds_dwordx4 %1, off\n\ts_mov_b32 m0, %0":"=&s"(keep):"v"(gsrc),"s"(lds_dst):"memory");}
__device__ __forceinline__ float max3f(float a,float b,float c){float r;asm("v_max3_f32 %0, %1, %2, %3":"=v"(r):"v"(a),"v"(b),"v"(c));return r;}
__device__ __forceinline__ float max2f(float a,float b){float r;asm("v_max_f32_e32 %0, %1, %2":"=v"(r):"v"(a),"v"(b));return r;}
__device__ __forceinline__ float fadd_s(float a,float b){float r;asm("v_add_f32_e32 %0, %1, %2":"=v"(r):"v"(a),"v"(b));return r;}
__device__ __forceinline__ float fsub_s(float a,float b){float r;asm("v_sub_f32_e32 %0, %1, %2":"=v"(r):"v"(a),"v"(b));return r;}
typedef float f32x2_t __attribute__((ext_vector_type(2))); typedef __bf16 bf16x2_t __attribute__((ext_vector_type(2)));
__device__ __forceinline__ unsigned cvtpk_s(float lo,float hi){f32x2_t v={lo,hi};bf16x2_t b=__builtin_convertvector(v,bf16x2_t);return __builtin_bit_cast(unsigned,b);}
#define WAIT_BAR(N) asm volatile("s_waitcnt vmcnt(" #N ") lgkmcnt(0)\n\ts_barrier":::"memory")

__device__ __forceinline__ void qkt(f32x16&p0,f32x16&p1,const char*Kslot,const bf16x8*qr,const f32x16&negm,int r32,int hi){
  const char*kb=Kslot+hi*1024+r32*16;
  #pragma unroll
  for(int d0=0;d0<4;++d0){
    const bf16x8 b0=*reinterpret_cast<const bf16x8*>(kb+d0*2048);
    const bf16x8 b1=*reinterpret_cast<const bf16x8*>(kb+d0*2048+512);
    if(d0==0){p0=__builtin_amdgcn_mfma_f32_32x32x16_bf16(b0,qr[0],negm,0,0,0);p1=__builtin_amdgcn_mfma_f32_32x32x16_bf16(b1,qr[0],negm,0,0,0);}
    else{p0=__builtin_amdgcn_mfma_f32_32x32x16_bf16(b0,qr[d0],p0,0,0,0);p1=__builtin_amdgcn_mfma_f32_32x32x16_bf16(b1,qr[d0],p1,0,0,0);}}
}
typedef __attribute__((address_space(3))) const char* lds_cptr;
typedef short v4i16_t __attribute__((ext_vector_type(4)));
__device__ __forceinline__ void kload8(bf16x8*kf,lds_cptr kp){
  kf[0]=*(const __attribute__((address_space(3))) bf16x8*)(kp);      kf[1]=*(const __attribute__((address_space(3))) bf16x8*)(kp+512);
  kf[2]=*(const __attribute__((address_space(3))) bf16x8*)(kp+2048); kf[3]=*(const __attribute__((address_space(3))) bf16x8*)(kp+2560);
  kf[4]=*(const __attribute__((address_space(3))) bf16x8*)(kp+4096); kf[5]=*(const __attribute__((address_space(3))) bf16x8*)(kp+4608);
  kf[6]=*(const __attribute__((address_space(3))) bf16x8*)(kp+6144); kf[7]=*(const __attribute__((address_space(3))) bf16x8*)(kp+6656);
}
__device__ __forceinline__ void kload2(bf16x8*kf,lds_cptr kp,int j){ kf[2*j]=*(const __attribute__((address_space(3))) bf16x8*)(kp+j*2048); kf[2*j+1]=*(const __attribute__((address_space(3))) bf16x8*)(kp+j*2048+512); }
__device__ __forceinline__ s16x4 vtr(lds_cptr p){ return __builtin_bit_cast(s16x4,__builtin_amdgcn_ds_read_tr16_b64_v4i16((__attribute__((address_space(3))) v4i16_t*)p)); }
__device__ __forceinline__ float rowmax(const f32x16&p0,const f32x16&p1){
  float a=max3f(p0[0],p0[1],p1[0]),b=max3f(p0[2],p0[3],p1[1]);a=max3f(a,p1[2],p1[3]);
  #pragma unroll
  for(int r=4;r<16;r+=4){a=max3f(a,p0[r],p0[r+1]);b=max3f(b,p0[r+2],p0[r+3]);a=max3f(a,p1[r],p1[r+1]);b=max3f(b,p1[r+2],p1[r+3]);}
  const float m=max2f(a,b);
  auto rr=__builtin_amdgcn_permlane32_swap(__float_as_uint(m),__float_as_uint(m),false,false);
  return max2f(__uint_as_float(rr[0]),__uint_as_float(rr[1]));
}
__device__ __forceinline__ void pv(f32x16*o,int vb,bf16x8 pa0,bf16x8 pa1,bf16x8 pa2,bf16x8 pa3){
  #pragma unroll
  for(int d0=0;d0<2;++d0){s16x4 lo[4],hi[4];
    #pragma unroll
    for(int ks=0;ks<4;++ks){
      asm volatile("ds_read_b64_tr_b16 %0,%1 offset:%c2":"=&v"(lo[ks]):"v"(vb),"i"(d0*4096+ks*1024):"memory");
      asm volatile("ds_read_b64_tr_b16 %0,%1 offset:%c2":"=&v"(hi[ks]):"v"(vb),"i"(d0*4096+ks*1024+512):"memory");}
    asm volatile("s_waitcnt lgkmcnt(0)":::"memory");SBAR();
    #define PK(k) (bf16x8){lo[k][0],lo[k][1],lo[k][2],lo[k][3],hi[k][0],hi[k][1],hi[k][2],hi[k][3]}
    o[d0]=__builtin_amdgcn_mfma_f32_32x32x16_bf16(pa0,PK(0),o[d0],0,0,0);
    o[d0]=__builtin_amdgcn_mfma_f32_32x32x16_bf16(pa1,PK(1),o[d0],0,0,0);
    o[d0]=__builtin_amdgcn_mfma_f32_32x32x16_bf16(pa2,PK(2),o[d0],0,0,0);
    o[d0]=__builtin_amdgcn_mfma_f32_32x32x16_bf16(pa3,PK(3),o[d0],0,0,0);
    #undef PK
  }
}

#ifndef ATTN_STORE16
#define ATTN_STORE16(p,v) (*(u32x4*)(p)=(v))
#endif
struct AttnUnitArgs { const bf16* Q; long qp; const bf16* K0; const bf16* V0; const bf16* K1; const bf16* V1; long kp; int tsplit, tmax, NT; bf16* O; long op; int r0, krow0; const float* rpb; };
template<int MODE,int THRL> __device__ __forceinline__ void attn_unit(const AttnUnitArgs&A,char*shm){
  const int tid=tid_now(),lane=tid&63,r32=lane&31,hi=lane>>5; const int wid=__builtin_amdgcn_readfirstlane(tid>>6);
  const long DMk=A.kp;
  const bf16*Qw=A.Q+(long)(wid*QBLK)*A.qp;
  const unsigned lds0=(unsigned)(uintptr_t)shm;
  float*wsf=(float*)(shm+LDS_WS)+wid*64;
  const long klane=(long)lane*DMk+wid*8;
  const long vlane=(long)(16*(wid&3)+(lane>>2))*DMk+(wid>>2)*32+(lane&3)*8;
  const int tsplit=A.tsplit,tmax=A.tmax;
  #define TOFF(t) ((long)(((t)-tsplit)>tmax?tmax:((t)-tsplit))*KVBLK*DMk)
  const unsigned kdst=lds0+LDS_K+wid*1024, vdst=lds0+LDS_V+wid*1024;
  #define DMA_K(t,slot) glds16(((t)<tsplit?A.K0+(long)(t)*KVBLK*DMk:A.K1+TOFF(t))+klane,(unsigned)__builtin_amdgcn_readfirstlane(kdst+(slot)))
  #define DMA_V(t,slot) glds16(((t)<tsplit?A.V0+(long)(t)*KVBLK*DMk:A.V1+TOFF(t))+vlane,(unsigned)__builtin_amdgcn_readfirstlane(vdst+(slot)))
  const int vb0=(int)(lds0+LDS_V)+((lane>>4)&1)*32+(lane&3)*8+(4*hi+((lane&15)>>2))*64;
  const char*Kbase=shm+LDS_K; bf16x8 kf[8];
  const lds_cptr shm3=(lds_cptr)shm; const lds_cptr kp0=shm3+LDS_K+hi*1024+r32*16; const lds_cptr vp0=shm3+LDS_V+((lane>>4)&1)*32+(lane&3)*8+(4*hi+((lane&15)>>2))*64;
  const int NT=A.NT;
  const lds_cfptr tab=(lds_cfptr)(shm3+LDS_BYTES);
  if(MODE==1){ __attribute__((address_space(3))) float* tw=(__attribute__((address_space(3))) float*)(shm3+LDS_BYTES); for(int i=tid;i<465;i+=512)tw[i]=A.rpb[i]*1.4426950408889634f; }
  const int nqr=A.r0+(wid>>1), nqc=(wid&1)*32+r32;
  DMA_K(0,0);DMA_V(0,0);DMA_K(1,SLOTB);
  if(wid>=4)__builtin_amdgcn_s_setprio(1);
  bf16x8 qr[4];
  #pragma unroll
  for(int d0=0;d0<4;++d0)qr[d0]=*reinterpret_cast<const bf16x8*>(&Qw[(long)r32*A.qp+d0*16+hi*8]);
  float mhat=0.f,l_reg=0.f;f32x16 o[2];o[0]=f32x16{};o[1]=f32x16{};f32x16 negm=f32x16{};asm volatile("":"+v"(negm));
  #define CMASK(P0,P1,t) do{ if(MODE==1){ const int kt_=(t)-tsplit; if(kt_>=0)nmask(P0,P1,A.krow0+kt_,nqr,nqc,hi,tab); } }while(0)
  bool resc=false;
  #define START(P0,P1) do{ const float rm=rowmax(P0,P1); resc=false; \
    { const float dl=rm; mhat=fadd_s(mhat,dl); \
      _Pragma("unroll") for(int r=0;r<16;++r){P0[r]=fsub_s(P0[r],dl);P1[r]=fsub_s(P1[r],dl);} \
      _Pragma("unroll") for(int r=0;r<16;++r)negm[r]=-mhat; asm volatile("":"+v"(negm)); } \
    _Pragma("unroll") for(int r=0;r<16;++r)P0[r]=__builtin_amdgcn_exp2f(P0[r]); }while(0)
  #define RESC() do{ if(resc){ asm volatile("s_waitcnt lgkmcnt(0)":::"memory"); \
      _Pragma("unroll") for(int d_=0;d_<2;++d_) _Pragma("unroll") for(int r=0;r<16;++r)o[d_][r]*=wsf[crow(r,hi)]; } }while(0)
  f32x16 pA0,pA1,pB0,pB1;
  int sl_prev=0,sl_cur=0,sl_next=SLOTB;
  #define ROT() do{sl_prev=sl_cur;sl_cur=sl_next;sl_next=(sl_next==(NSLOT-1)*SLOTB)?0:sl_next+SLOTB;}while(0)
  DMA_K(2,2*SLOTB);
  WAIT_BAR(3);
  qkt(pA0,pA1,Kbase,qr,negm,r32,hi);asm volatile("s_nop 15\n\ts_nop 7":"+v"(pA0),"+v"(pA1));CMASK(pA0,pA1,0);
  START(pA0,pA1);
  _Pragma("unroll") for(int r=0;r<16;++r)pA1[r]=__builtin_amdgcn_exp2f(pA1[r]);
  WAIT_BAR(0);
  DMA_K(3,0);DMA_V(1,SLOTB);
  ROT();
  kload8(kf,kp0+sl_cur);
  WAIT_BAR(2);
  s16x4 vlo[8],vhi[8]; u32x4 pw0,pw1,pw2,pw3;
  #define PKW(P,B) cvtpk_s(P[B],P[B+1])
  #define PAF(k) __builtin_bit_cast(bf16x8,pw##k)
  #define VFR(i) (bf16x8){vlo[i][0],vlo[i][1],vlo[i][2],vlo[i][3],vhi[i][0],vhi[i][1],vhi[i][2],vhi[i][3]}
  #define PIN(x) asm volatile("":"+v"(x))
  #define MX3(a,b,c) __builtin_fmaxf(__builtin_fmaxf((a),(b)),(c))
  #define GAPA(MF,A0,A1,A2,A3,W0,W1,PW) do{ MF; sacc+=A0; sacc+=A1; sacc+=A2; sacc+=A3; PIN(sacc); W0; W1; PIN(PW); SBAR(); }while(0)
  #define EX(v) __builtin_amdgcn_exp2f(v)
  #define GAPB(MF,X,B) do{ MF; X[B]=EX(X[B]); X[B+1]=EX(X[B+1]); X[B+2]=EX(X[B+2]); X[B+3]=EX(X[B+3]); PIN(X); SBAR(); }while(0)
  #define VRD(i) do{ vlo[i]=vtr(vp_+(((i)>>2)*4096+((i)&3)*1024)); vhi[i]=vtr(vp_+(((i)>>2)*4096+((i)&3)*1024+512)); }while(0)
  #define KRD(G,j) do{ if(G){ kload2(kf,kp0+sl_next,j); SBAR(); } }while(0)
  #define STEP(C0,C1,P0,P1,t,GK,GV,GL) do{ SBAR(); \
    const lds_cptr vp_=vp0+sl_prev; \
    VRD(0); SBAR(); float sacc=(P0[0]+P0[1]); \
    GAPA(C0=__builtin_amdgcn_mfma_f32_32x32x16_bf16(kf[0],qr[0],negm,0,0,0), P0[2],P0[3],P0[4],P0[5],     pw0[0]=PKW(P0,0), pw0[1]=PKW(P0,2), pw0); \
    VRD(4); SBAR(); GAPA(C1=__builtin_amdgcn_mfma_f32_32x32x16_bf16(kf[1],qr[0],negm,0,0,0), P0[6],P0[7],P0[8],P0[9],     pw0[2]=PKW(P0,4), pw0[3]=PKW(P0,6), pw0); \
    VRD(1); SBAR(); GAPA(C0=__builtin_amdgcn_mfma_f32_32x32x16_bf16(kf[2],qr[1],C0,0,0,0),   P0[10],P0[11],P0[12],P0[13], pw1[0]=PKW(P0,8), pw1[1]=PKW(P0,10), pw1); \
    VRD(5); SBAR(); GAPA(C1=__builtin_amdgcn_mfma_f32_32x32x16_bf16(kf[3],qr[1],C1,0,0,0),   P0[14],P0[15],P1[0],P1[1],   pw1[2]=PKW(P0,12),pw1[3]=PKW(P0,14), pw1); \
    VRD(2); SBAR(); GAPA(C0=__builtin_amdgcn_mfma_f32_32x32x16_bf16(kf[4],qr[2],C0,0,0,0),   P1[2],P1[3],P1[4],P1[5],     pw2[0]=PKW(P1,0), pw2[1]=PKW(P1,2), pw2); \
    VRD(6); SBAR(); GAPA(C1=__builtin_amdgcn_mfma_f32_32x32x16_bf16(kf[5],qr[2],C1,0,0,0),   P1[6],P1[7],P1[8],P1[9],     pw2[2]=PKW(P1,4), pw2[3]=PKW(P1,6), pw2); \
    VRD(3); SBAR(); GAPA(C0=__builtin_amdgcn_mfma_f32_32x32x16_bf16(kf[6],qr[3],C0,0,0,0),   P1[10],P1[11],P1[12],P1[13], pw3[0]=PKW(P1,8), pw3[1]=PKW(P1,10), pw3); \
    VRD(7); SBAR(); GAPA(C1=__builtin_amdgcn_mfma_f32_32x32x16_bf16(kf[7],qr[3],C1,0,0,0),   P1[14],P1[15],0.f,0.f,       pw3[2]=PKW(P1,12),pw3[3]=PKW(P1,14), pw3); \
    l_reg+=sacc; \
    if(GK){DMA_K((t)+3,sl_cur);} if(GV){DMA_V((t)+1,sl_next);} \
    CMASK(C0,C1,t); \
    { float a=MX3(C0[0],C0[1],C1[0]),b=MX3(C0[2],C0[3],C1[1]); a=MX3(a,C1[2],C1[3]); \
      _Pragma("unroll") for(int r=4;r<16;r+=4){a=MX3(a,C0[r],C0[r+1]);b=MX3(b,C0[r+2],C0[r+3]);a=MX3(a,C1[r],C1[r+1]);b=MX3(b,C1[r+2],C1[r+3]);} \
      float rm=__builtin_fmaxf(a,b); { auto rr=__builtin_amdgcn_permlane32_swap(__float_as_uint(rm),__float_as_uint(rm),false,false); rm=__builtin_fmaxf(__uint_as_float(rr[0]),__uint_as_float(rr[1])); } \
      resc=false; \
      if(__builtin_expect(__any(rm>(float)THRL),0)){ const float dl=__builtin_fmaxf(rm,0.f); mhat+=dl; \
        _Pragma("unroll") for(int r=0;r<16;++r){C0[r]-=dl;C1[r]-=dl;} \
        _Pragma("unroll") for(int r=0;r<16;++r)negm[r]=-mhat; asm volatile("":"+v"(negm)); \
        const float f=__builtin_amdgcn_exp2f(-dl); l_reg*=f; if(hi==0)wsf[r32]=f; resc=true; } } \
    SBAR(); \
    GAPB(o[0]=__builtin_amdgcn_mfma_f32_32x32x16_bf16(PAF(0),VFR(0),o[0],0,0,0), C0,0); \
    GAPB(o[1]=__builtin_amdgcn_mfma_f32_32x32x16_bf16(PAF(0),VFR(4),o[1],0,0,0), C0,4); \
    KRD(GL,0); GAPB(o[0]=__builtin_amdgcn_mfma_f32_32x32x16_bf16(PAF(1),VFR(1),o[0],0,0,0), C0,8); \
    KRD(GL,1); GAPB(o[1]=__builtin_amdgcn_mfma_f32_32x32x16_bf16(PAF(1),VFR(5),o[1],0,0,0), C0,12); \
    KRD(GL,2); GAPB(o[0]=__builtin_amdgcn_mfma_f32_32x32x16_bf16(PAF(2),VFR(2),o[0],0,0,0), C1,0); \
    KRD(GL,3); GAPB(o[1]=__builtin_amdgcn_mfma_f32_32x32x16_bf16(PAF(2),VFR(6),o[1],0,0,0), C1,4); \
    GAPB(o[0]=__builtin_amdgcn_mfma_f32_32x32x16_bf16(PAF(3),VFR(3),o[0],0,0,0), C1,8); \
    GAPB(o[1]=__builtin_amdgcn_mfma_f32_32x32x16_bf16(PAF(3),VFR(7),o[1],0,0,0), C1,12); \
    }while(0)
  int t=1;
  for(;t+5<NT;t+=2){
    STEP(pB0,pB1,pA0,pA1,t,true,true,true);     WAIT_BAR(2); RESC(); ROT();
    STEP(pA0,pA1,pB0,pB1,t+1,true,true,true);   WAIT_BAR(2); RESC(); ROT();
  }
  #undef CMASK
  #define CMASK(P0,P1,t) do{ if(MODE==1){ const int kt_=(t)-tsplit; if(kt_>=0)nmask(P0,P1,A.krow0+kt_,nqr,nqc,hi,tab); } }while(0)
  #define ENDW(tt) do{ if((tt)+3<NT){WAIT_BAR(2);} else if((tt)+2<NT){WAIT_BAR(1);} else {WAIT_BAR(0);} }while(0)
  for(;t+1<NT;t+=2){
    STEP(pB0,pB1,pA0,pA1,t,(t+3<NT),(t+1<NT),(t+1<NT));       ENDW(t);   RESC(); ROT();
    STEP(pA0,pA1,pB0,pB1,t+1,(t+4<NT),(t+2<NT),(t+2<NT));     ENDW(t+1); RESC(); ROT();
  }
  STEP(pB0,pB1,pA0,pA1,NT-1,false,false,false); RESC();
  { float sacc=pB0[0]+pB0[1]; _Pragma("unroll") for(int r=2;r<16;++r)sacc+=pB0[r]; _Pragma("unroll") for(int r=0;r<16;++r)sacc+=pB1[r]; l_reg+=sacc;
    pw0=(u32x4){PKW(pB0,0),PKW(pB0,2),PKW(pB0,4),PKW(pB0,6)};pw1=(u32x4){PKW(pB0,8),PKW(pB0,10),PKW(pB0,12),PKW(pB0,14)};pw2=(u32x4){PKW(pB1,0),PKW(pB1,2),PKW(pB1,4),PKW(pB1,6)};pw3=(u32x4){PKW(pB1,8),PKW(pB1,10),PKW(pB1,12),PKW(pB1,14)};
    SBAR(); pv(o,vb0+sl_cur,PAF(0),PAF(1),PAF(2),PAF(3)); }
  #undef PKW
  #undef PAF
  #undef VFR
  #undef PIN
  #undef MX3
  #undef GAPA
  #undef GAPB
  #undef EX
  #undef VRD
  #undef KRD
  #undef STEP
  #undef ENDW
  {auto rr=__builtin_amdgcn_permlane32_swap(__float_as_uint(l_reg),__float_as_uint(l_reg),false,false);l_reg=__uint_as_float(rr[0])+__uint_as_float(rr[1]);}
  if(hi==0)wsf[32+r32]=l_reg;asm volatile("s_waitcnt lgkmcnt(0)":::"memory");
  float rli[16];
  #pragma unroll
  for(int r=0;r<16;++r)rli[r]=__builtin_amdgcn_rcpf(wsf[32+crow(r,hi)]);
  bf16*Ow=A.O+(long)(wid*QBLK)*A.op;
  { bf16*stg=(bf16*)(shm+LDS_OST)+wid*2048;
    #pragma unroll
    for(int r=0;r<16;++r){const int orow=crow(r,hi);
      #pragma unroll
      for(int d0=0;d0<2;++d0)stg[orow*64+d0*32+r32]=__float2bfloat16(o[d0][r]*rli[r]);}
    asm volatile("s_waitcnt lgkmcnt(0)":::"memory");
    #pragma unroll
    for(int i=0;i<4;++i){const int row=i*8+(lane>>3),ch=lane&7; const u32x4 v=*(const u32x4*)(stg+row*64+ch*8); ATTN_STORE16(Ow+(long)row*A.op+ch*8,v);} }
  __builtin_amdgcn_s_setprio(0);
  asm volatile("s_waitcnt lgkmcnt(0)\n\ts_barrier":::"memory");
  #undef DMA_K
  #undef TOFF
  #undef DMA_V
  #undef CMASK
  #undef START
  #undef RESC
  #undef ROT
}
constexpr int ATTN_LDS_BYTES=LDS_BYTES+2048;
#undef SBAR
#undef WAIT_BAR
}
static_assert(attn_body::ATTN_LDS_BYTES <= RING_BYTES, "attention scratch fits the ring");

#define GAS __attribute__((address_space(1)))
#define LAS __attribute__((address_space(3)))
typedef unsigned short bf16;
typedef unsigned v4u __attribute__((ext_vector_type(4)));
typedef unsigned v2u __attribute__((ext_vector_type(2)));
typedef float f32x4 __attribute__((ext_vector_type(4)));
#define LDS_WAIT() asm volatile("s_waitcnt lgkmcnt(0)" ::: "memory")
__device__ __forceinline__ unsigned f2bf(float f) { unsigned u = __builtin_bit_cast(unsigned, f); return (u + 0x7fffu + ((u >> 16) & 1u)) >> 16; }
__device__ __forceinline__ unsigned pk2(float lo, float hi) { return f2bf(lo) | (f2bf(hi) << 16); }
__device__ __forceinline__ float bf_lo(unsigned w) { return __builtin_bit_cast(float, w << 16); }
__device__ __forceinline__ float bf_hi(unsigned w) { return __builtin_bit_cast(float, w & 0xffff0000u); }
__device__ __forceinline__ float wave_sum(float v) {
#pragma unroll
    for (int o = 1; o < 64; o <<= 1) v += __shfl_xor(v, o);
    return v;
}

typedef GAS unsigned gu32;
#define RLX_AGENT __ATOMIC_RELAXED, __HIP_MEMORY_SCOPE_AGENT
#define XB_TMO      128
#define XB_XCNT(j)  (256  + 64 * (j))
#define XB_XSUB(j)  (1280 + 64 * (j))
#define XB_XGEN(j)  (2304 + 64 * (j))
#define XB_TOP      3328
#define XB_TOPGEN   3392
#define XCD_BAR_WORDS 3456
#define XB_SPIN_CAP (1u << 18)

__device__ __forceinline__ unsigned xb_ld(unsigned* p)              { return __hip_atomic_load(p, __ATOMIC_RELAXED, __HIP_MEMORY_SCOPE_AGENT); }
__device__ __forceinline__ unsigned xb_add(unsigned* p, unsigned v) { return __hip_atomic_fetch_add(p, v, __ATOMIC_RELAXED, __HIP_MEMORY_SCOPE_AGENT); }
__device__ __forceinline__ unsigned xb_xcc_id() { return (unsigned)__builtin_amdgcn_s_getreg((3 << 11) | 20) & 0xFu; }
#define XB_SPIN(cond, bar) do { unsigned _sp = 0; while (cond) { __builtin_amdgcn_s_sleep(1); \
    if ((++_sp & 255u) == 0u) { if (xb_ld(&(bar)[XB_TMO])) break; if (_sp > XB_SPIN_CAP) { atomicAdd(&(bar)[XB_TMO], 1u); break; } } } } while (0)

struct XcdBarrier {
    unsigned* bar; unsigned x;
    volatile LAS unsigned* st;
};

__device__ __forceinline__ XcdBarrier xcd_barrier_post(unsigned* bar, volatile LAS unsigned* st) {
    XcdBarrier b; b.bar = bar; b.x = xb_xcc_id(); b.st = st;
    if (threadIdx.x == 0) (void)xb_add(&bar[XB_XCNT(b.x)], 1u);
    return b;
}
__device__ __forceinline__ void xcd_barrier_complete(unsigned* bar, unsigned x, unsigned& nloc, unsigned& nx) {
    const unsigned G = gridDim.x * gridDim.y * gridDim.z;
    unsigned sum, cnt, mine, sp = 0u;
    for (;;) {
        sum = 0u; cnt = 0u; mine = 0u;
#pragma unroll
        for (unsigned j = 0; j < 16; ++j) { const unsigned c = xb_ld(&bar[XB_XCNT(j)]); sum += c; cnt += (c > 0u) ? 1u : 0u; mine = (j == x) ? c : mine; }
        if (sum == G) break;
        __builtin_amdgcn_s_sleep(1);
        if ((++sp & 255u) == 0u) { if (xb_ld(&bar[XB_TMO])) break; if (sp > XB_SPIN_CAP) { atomicAdd(&bar[XB_TMO], 1u); break; } }
    }
    nloc = mine > 0u ? mine : 1u; nx = cnt > 0u ? cnt : 1u;
}

__device__ __forceinline__ void xcd_barrier(const XcdBarrier& b) {
    asm volatile("s_waitcnt vmcnt(0)" ::: "memory");
    __syncthreads();
    if (threadIdx.x == 0) {
        unsigned* bar = b.bar;
        __builtin_amdgcn_s_waitcnt(0);
        unsigned nloc = b.st[0], nx = b.st[1];
        if (nloc == 0u) { xcd_barrier_complete(bar, b.x, nloc, nx); b.st[0] = nloc; b.st[1] = nx; }
        const unsigned old = xb_add(&bar[XB_XSUB(b.x)], 1u);
        const unsigned gen = old / nloc;
        if (old + 1u == (gen + 1u) * nloc) {
            __builtin_amdgcn_fence(__ATOMIC_RELEASE, "agent");
            asm volatile("s_waitcnt vmcnt(0)" ::: "memory");
            const unsigned og = xb_add(&bar[XB_TOP], 1u);
            const unsigned tg = og / nx;
            if (og + 1u == (tg + 1u) * nx) xb_add(&bar[XB_TOPGEN], 1u);
            else XB_SPIN(xb_ld(&bar[XB_TOPGEN]) == tg, bar);
            __builtin_amdgcn_fence(__ATOMIC_ACQUIRE, "agent");
            xb_add(&bar[XB_XGEN(b.x)], 1u);
            asm volatile("s_waitcnt vmcnt(0)" ::: "memory");
        } else {
            XB_SPIN(xb_ld(&bar[XB_XGEN(b.x)]) == gen, bar);
            __builtin_amdgcn_fence(__ATOMIC_ACQUIRE, "agent");
            asm volatile("s_waitcnt vmcnt(0)" ::: "memory");
        }
    }
    __syncthreads();
}

struct Args { const float* in[23]; float* out; unsigned char* ws; };
typedef const __attribute__((address_space(4))) Args* KArgs;
enum { I_XP = 0, I_XS, I_CNBK, I_CNBV, I_CATK, I_CATV, I_C, I_CCTX, I_WMOD, I_BMOD, I_GNORM, I_WFI, I_WFO, I_WIAB, I_WPOOL, I_PSCALE, I_RPB, I_WOAB, I_WQKV, I_GQ, I_GK, I_WOC, I_GFINAL };

__device__ __forceinline__ void tr_item(const float* W, int ldw, int k0, int n0, bf16* WT, int ldt, int nrow0, int kdst0, LAS float* scr, int lane) {
    float tv[32];
#pragma unroll
    for (int i = 0; i < 32; ++i) { const int kk = 2 * i + (lane >> 5); tv[i] = W[(size_t)(k0 + kk) * ldw + n0 + (lane & 31)]; }
#pragma unroll
    for (int i = 0; i < 32; ++i) { const int kk = 2 * i + (lane >> 5); scr[kk * 33 + (lane & 31)] = tv[i]; }
    LDS_WAIT(); asm volatile("" ::: "memory");
    const int c = lane & 7;
#pragma unroll
    for (int j = 0; j < 4; ++j) { const int n = (lane >> 3) + 8 * j; const LAS float* s = scr + (8 * c) * 33 + n;
        v4u o; o.x = pk2(s[0 * 33], s[1 * 33]); o.y = pk2(s[2 * 33], s[3 * 33]); o.z = pk2(s[4 * 33], s[5 * 33]); o.w = pk2(s[6 * 33], s[7 * 33]);
        *(v4u*)(WT + (size_t)(nrow0 + n) * ldt + kdst0 + 8 * c) = o; }
    LDS_WAIT(); asm volatile("" ::: "memory");
}

__device__ __forceinline__ void prologue_a(KArgs a, LAS unsigned char* lds, int vcu, int G, int wave, int lane) {
    unsigned char* ws = a->ws;
    LAS float* scr = (LAS float*)(lds + RING_OFF + wave * 16384);
    const int gw = vcu * NWAVES + wave, NGW = G * NWAVES;
    constexpr int N_ADA = 4 * 36 * ADA_KC;
    constexpr int I_FI = 16 * 176, I_FO = 44 * 32, I_IAB = 16 * 64, I_OAB = 8 * 32, I_QKV = 16 * 48, I_OC = 16 * 32;
    constexpr int N_TR = 8 * I_FI + 8 * I_FO + 2 * I_IAB + 2 * I_OAB + 2 * I_QKV + 2 * I_OC;
    constexpr int N_PW = 2 * 1024, N_CNB = 2 * 1024, N_CAT = 2 * 1024, N_ROPE = 16;
    constexpr int NTASK = N_ADA + N_PW + N_TR + N_CNB + N_CAT + N_ROPE;
    for (int it = gw; it < NTASK; it += NGW) {
        int r = it;
        if (r < N_ADA) {
            const int kc = r % ADA_KC, cb = (r / ADA_KC) % 36, l = r / (ADA_KC * 36);
            const float* W = a->in[I_WMOD] + ((size_t)l * 1024 + kc * 64) * 9216 + cb * 256 + lane * 4;
            float sv[5];
            { const int k = kc * 64 + lane; const float c0 = a->in[I_CCTX][k]; sv[0] = pg8::silu_f(c0);
#pragma unroll
              for (int ms = 1; ms < 5; ++ms) sv[ms] = pg8::silu_f(a->in[I_C][(ms - 1) * 1024 + k]); }
            f32x4 acc[5];
#pragma unroll
            for (int ms = 0; ms < 5; ++ms) acc[ms] = (f32x4){0.f, 0.f, 0.f, 0.f};
#pragma unroll 16
            for (int kk = 0; kk < 64; ++kk) { const f32x4 w = *(const f32x4*)(W + (size_t)kk * 9216);
#pragma unroll
                for (int ms = 0; ms < 5; ++ms) { const float s = __builtin_bit_cast(float, __builtin_amdgcn_readlane(__builtin_bit_cast(int, sv[ms]), kk)); acc[ms] += w * s; } }
            float* P = (float*)(ws + WS_MODP);
#pragma unroll
            for (int ms = 0; ms < 5; ++ms) *(f32x4*)(P + ((size_t)(kc * 4 + l) * 5 + ms) * 9216 + cb * 256 + lane * 4) = acc[ms];
            continue;
        }
        r -= N_ADA;
        if (r < N_PW) {
            const int e = r >> 10, rr = r & 1023, k0 = (rr >> 4) * 8, n = (rr & 15) * 64 + lane, g = k0 >> 7, c0 = k0 & 127;
            const float* wo = a->in[I_WOAB] + (size_t)e * 1024 * 1024 + (size_t)(g * 128) * 1024 + n;
            const float* ps = a->in[I_PSCALE] + e * 512 + g * 128;
            const float* wp = a->in[I_WPOOL] + ((size_t)(e * 4 + g) * 128 + c0) * 128;
            float acc[8];
#pragma unroll
            for (int j = 0; j < 8; ++j) acc[j] = 0.f;
#pragma unroll 16
            for (int d = 0; d < 128; ++d) { const float w = wo[(size_t)d * 1024] * ps[d];
#pragma unroll
                for (int j = 0; j < 8; ++j) acc[j] += wp[j * 128 + d] * w; }
            v4u o; o.x = pk2(acc[0], acc[1]); o.y = pk2(acc[2], acc[3]); o.z = pk2(acc[4], acc[5]); o.w = pk2(acc[6], acc[7]);
            *(v4u*)((bf16*)(ws + WS_WOAB) + (size_t)e * 1024 * 1024 + (size_t)n * 1024 + k0) = o;
            continue;
        }
        r -= N_PW;
        if (r < N_TR) {
            if (r < 8 * I_FI) { const int mat = r / I_FI, it2 = r % I_FI, kb = it2 / 176, nb = it2 % 176; const int n0 = 32 * nb; const int bj = n0 >= DFF ? 1 : 0, j = n0 - bj * DFF;
                tr_item(a->in[I_WFI] + (size_t)mat * 1024 * NFF, NFF, 64 * kb, n0, (bf16*)(ws + WS_WFI) + (size_t)mat * NFF * 1024, 1024, 256 * (j >> 7) + 128 * bj + (j & 127), 64 * kb, scr, lane); continue; }
            r -= 8 * I_FI;
            if (r < 8 * I_FO) { const int mat = r / I_FO, it2 = r % I_FO, kb = it2 / 32, nb = it2 % 32; const int k0 = 64 * kb; constexpr int KC = DFF / FFO_KS; const int ks = k0 / KC;
                tr_item(a->in[I_WFO] + (size_t)mat * DFF * 1024, 1024, k0, 32 * nb, (bf16*)(ws + WS_WFO) + (size_t)mat * DFF * 1024 + (size_t)ks * 1024 * KC, KC, 32 * nb, k0 - ks * KC, scr, lane); continue; }
            r -= 8 * I_FO;
            if (r < 2 * I_IAB) { const int e = r / I_IAB, it2 = r % I_IAB, kb = it2 / 64, nb = it2 % 64;
                tr_item(a->in[I_WIAB] + (size_t)e * 1024 * 2048, 2048, 64 * kb, 32 * nb, (bf16*)(ws + WS_WIAB) + (size_t)e * 2048 * 1024, 1024, 32 * nb, 64 * kb, scr, lane); continue; }
            r -= 2 * I_IAB;
            if (r < 2 * I_OAB) { const int e = r / I_OAB, it2 = r % I_OAB, kb = it2 / 32, nb = it2 % 32; constexpr int KC = 1024 / OUT_KS; const int kd = 512 + 64 * kb, ks = kd / KC;
                tr_item(a->in[I_WOAB] + (size_t)e * 1024 * 1024 + (size_t)512 * 1024, 1024, 64 * kb, 32 * nb, (bf16*)(ws + WS_WOAB) + (size_t)e * 1024 * 1024 + (size_t)ks * 1024 * KC, KC, 32 * nb, kd - ks * KC, scr, lane); continue; }
            r -= 2 * I_OAB;
            if (r < 2 * I_QKV) { const int o = r / I_QKV, it2 = r % I_QKV, kb = it2 / 48, nb = it2 % 48;
                tr_item(a->in[I_WQKV] + (size_t)o * 1024 * 1536, 1536, 64 * kb, 32 * nb, (bf16*)(ws + WS_WQKV) + (size_t)o * 1536 * 1024, 1024, 32 * nb, 64 * kb, scr, lane); continue; }
            r -= 2 * I_QKV;
            { const int o = r / I_OC, it2 = r % I_OC, kb = it2 / 32, nb = it2 % 32; constexpr int KC = 1024 / OUT_KS; const int k0 = 64 * kb, ks = k0 / KC;
                tr_item(a->in[I_WOC] + (size_t)o * 1024 * 1024, 1024, k0, 32 * nb, (bf16*)(ws + WS_WOC) + (size_t)o * 1024 * 1024 + (size_t)ks * 1024 * KC, KC, 32 * nb, k0 - ks * KC, scr, lane); continue; }
        }
        r -= N_TR;
        if (r < N_CNB) {
            const int e = r >> 10, rr = r & 1023, b = rr >> 8, s = rr & 255;
            const size_t so = ((size_t)(b * 2 + e) * 256 + s) * 512 + lane * 8;
            bf16* dst = (bf16*)(ws + WS_CTXNB) + (size_t)e * 1024 * 2048 + (size_t)rr * 2048 + lane * 8;
            { const f32x4 x0 = *(const f32x4*)(a->in[I_CNBK] + so), x1 = *(const f32x4*)(a->in[I_CNBK] + so + 4); v4u o; o.x = pk2(x0[0], x0[1]); o.y = pk2(x0[2], x0[3]); o.z = pk2(x1[0], x1[1]); o.w = pk2(x1[2], x1[3]); *(v4u*)(dst + 1024) = o; }
            { const f32x4 x0 = *(const f32x4*)(a->in[I_CNBV] + so), x1 = *(const f32x4*)(a->in[I_CNBV] + so + 4); v4u o; o.x = pk2(x0[0], x0[1]); o.y = pk2(x0[2], x0[3]); o.z = pk2(x1[0], x1[1]); o.w = pk2(x1[2], x1[3]); *(v4u*)(dst + 1536) = o; }
            continue;
        }
        r -= N_CNB;
        if (r < N_CAT) {
            const int o = r >> 10, rr = r & 1023, b = rr >> 8, s = rr & 255;
            const size_t so = ((size_t)(b * 2 + o) * 256 + s) * 256 + lane * 4; const size_t dofs = (size_t)o * KCAT_STRIDE + ((size_t)b * 4352 + s) * 256 + lane * 4;
            { const f32x4 x0 = *(const f32x4*)(a->in[I_CATK] + so); v2u w; w.x = pk2(x0[0], x0[1]); w.y = pk2(x0[2], x0[3]); *(v2u*)((bf16*)(ws + WS_KCAT) + dofs) = w; }
            { const f32x4 x0 = *(const f32x4*)(a->in[I_CATV] + so); v2u w; w.x = pk2(x0[0], x0[1]); w.y = pk2(x0[2], x0[3]); *(v2u*)((bf16*)(ws + WS_VCAT) + dofs) = w; }
            continue;
        }
        r -= N_CAT;
        {
            const int idx = r * 64 + lane, pos = idx >> 4, i = idx & 15;
            const float inv = __builtin_amdgcn_exp2f(-(float)i * (13.287712379549449f / 16.0f)), ang = (float)pos * inv;
            float* R = (float*)(ws + WS_ROPE); R[2 * idx] = __cosf(ang); R[2 * idx + 1] = __sinf(ang);
        }
    }
}
__device__ __forceinline__ void prologue_b(KArgs a, int vcu, int G, int tid) {
    const float* P = (const float*)(a->ws + WS_MODP); float* Mo = (float*)(a->ws + WS_MOD);
    for (int i = vcu * 512 + tid; i < 4 * 5 * 9216 / 4; i += G * 512) {
        const int j4 = i % 2304, lm = i / 2304, l = lm / 5;
        f32x4 s = *(const f32x4*)(a->in[I_BMOD] + l * 9216 + j4 * 4);
#pragma unroll
        for (int kc = 0; kc < ADA_KC; ++kc) s += *(const f32x4*)(P + ((size_t)kc * 20 + lm) * 9216 + j4 * 4);
        *(f32x4*)(Mo + (size_t)lm * 9216 + j4 * 4) = s;
    }
}
template <bool XH> __device__ __forceinline__ void norm_phase(const float* x0, const float* x1, const float* g, const float* mod, int ish, int isc, bf16* H, _Float16* xcopy, int vcu, int G, int wave, int lane) {
    const int gw = vcu * NWAVES + wave, NGW = G * NWAVES;
    for (int m = gw; m < T; m += NGW) {
        const float* xr = (m < TC ? x0 : x1) + (size_t)m * D; const int ms = m < TC ? 0 : 1 + ((m - TC) >> 12);
        const float* sh = mod + (ms * 9 + ish) * 1024; const float* sc = mod + (ms * 9 + isc) * 1024;
        f32x4 v[4]; float s = 0.f;
#pragma unroll
        for (int j = 0; j < 4; ++j) { if (XH) { typedef _Float16 h4 __attribute__((ext_vector_type(4))); const h4 t = *(const h4*)((const _Float16*)x0 + (size_t)m * D + 4 * lane + 256 * j); v[j] = (f32x4){(float)t[0], (float)t[1], (float)t[2], (float)t[3]}; } else v[j] = *(const f32x4*)(xr + 4 * lane + 256 * j);
            s += (v[j].x * v[j].x + v[j].y * v[j].y) + (v[j].z * v[j].z + v[j].w * v[j].w); }
        const float rstd = 1.0f / sqrtf(wave_sum(s) * (1.f / D) + EPS);
        if (!XH && xcopy) {
#pragma unroll
            for (int j = 0; j < 4; ++j) { typedef _Float16 h4 __attribute__((ext_vector_type(4))); const h4 t = {(_Float16)v[j].x, (_Float16)v[j].y, (_Float16)v[j].z, (_Float16)v[j].w}; *(h4*)(xcopy + (size_t)m * D + 4 * lane + 256 * j) = t; } }
#pragma unroll
        for (int j = 0; j < 4; ++j) { const int c = 4 * lane + 256 * j; const f32x4 gg = *(const f32x4*)(g + c), a = *(const f32x4*)(sc + c), b = *(const f32x4*)(sh + c);
            const f32x4 y = (v[j] * rstd * gg) * (a + 1.0f) + b; v2u w; w.x = pk2(y[0], y[1]); w.y = pk2(y[2], y[3]); *(v2u*)(H + (size_t)m * D + c) = w; }
    }
}
__device__ __forceinline__ void final_norm(const float* x0, const float* g, float* out, int vcu, int G, int wave, int lane) {
    constexpr bool XH = true;
    const int gw = vcu * NWAVES + wave, NGW = G * NWAVES;
    for (int m = gw; m < T; m += NGW) {
        const float* xr = x0; f32x4 v[4]; float s = 0.f;
#pragma unroll
        for (int j = 0; j < 4; ++j) { if (XH) { typedef _Float16 h4 __attribute__((ext_vector_type(4))); const h4 t = *(const h4*)((const _Float16*)x0 + (size_t)m * D + 4 * lane + 256 * j); v[j] = (f32x4){(float)t[0], (float)t[1], (float)t[2], (float)t[3]}; } else v[j] = *(const f32x4*)(xr + 4 * lane + 256 * j);
            s += (v[j].x * v[j].x + v[j].y * v[j].y) + (v[j].z * v[j].z + v[j].w * v[j].w); }
        const float rstd = 1.0f / sqrtf(wave_sum(s) * (1.f / D) + EPS);
#pragma unroll
        for (int j = 0; j < 4; ++j) { const int c = 4 * lane + 256 * j; *(f32x4*)(out + (size_t)m * D + c) = v[j] * rstd * *(const f32x4*)(g + c); }
    }
}
__device__ __forceinline__ void pool_phase(const bf16* P, bf16* A2, int vcu, int G, int wave, int lane) {
    const int gw = vcu * NWAVES + wave, NGW = G * NWAVES; const int grp = lane >> 4, w = 2 << grp, wl = w >> 1, wh = w - 1 - wl;
    for (int m = gw; m < T; m += NGW) {
        int s0, L, p; if (m < TC) { s0 = m & ~255; L = 256; p = m - s0; } else { s0 = TC + ((m - TC) & ~4095); L = 4096; p = m - s0; }
        int lo = p - wl; lo = lo < 0 ? 0 : lo; int hi = p + wh; hi = hi > L - 1 ? L - 1 : hi;
        v4u x[16];
#pragma unroll
        for (int j = 0; j < 16; ++j) { int q = p - 8 + j; q = q < 0 ? 0 : q; q = q > L - 1 ? L - 1 : q; x[j] = *(const v4u*)(P + (size_t)(s0 + q) * 2048 + lane * 8); }
        float acc[8];
#pragma unroll
        for (int j = 0; j < 8; ++j) acc[j] = 0.f;
#pragma unroll
        for (int j = 0; j < 16; ++j) { const int q = p - 8 + j; const float wt = (q >= lo && q <= hi) ? 1.0f : 0.0f;
            acc[0] += wt * bf_lo(x[j].x); acc[1] += wt * bf_hi(x[j].x); acc[2] += wt * bf_lo(x[j].y); acc[3] += wt * bf_hi(x[j].y); acc[4] += wt * bf_lo(x[j].z); acc[5] += wt * bf_hi(x[j].z); acc[6] += wt * bf_lo(x[j].w); acc[7] += wt * bf_hi(x[j].w); }
        const float ic = 1.0f / (float)(hi - lo + 1);
        const v4u c = x[8];
        v4u o; o.x = pk2(acc[0] * ic - bf_lo(c.x), acc[1] * ic - bf_hi(c.x)); o.y = pk2(acc[2] * ic - bf_lo(c.y), acc[3] * ic - bf_hi(c.y));
        o.z = pk2(acc[4] * ic - bf_lo(c.z), acc[5] * ic - bf_hi(c.z)); o.w = pk2(acc[6] * ic - bf_lo(c.w), acc[7] * ic - bf_hi(c.w));
        *(v4u*)(A2 + (size_t)m * 1024 + lane * 8) = o;
    }
}
__device__ __forceinline__ void qk_post(bf16* P, const float* gq, const float* gk, const float* rope, bf16* Kcat, bf16* Vcat, float* kout, int vcu, int G, int wave, int lane) {
    const int gw = vcu * NWAVES + wave, NGW = G * NWAVES; const int sub = lane & 7, d0 = sub * 8;
    for (int m = gw; m < T; m += NGW) {
        const bool lat = m >= TC; const int tl = (m - TC) & 4095, bb = (m - TC) >> 12;
        const int pos = (sub & 4) ? (tl & 63) : (tl >> 6);
        const float* rp = rope + (pos * 16 + (sub & 1) * 8) * 2;
#pragma unroll
        for (int pass = 0; pass < 3; ++pass) {
            const int hh = pass * 8 + (lane >> 3);
            bf16* src = P + (size_t)m * 1536 + hh * 64 + d0;
            const v4u x = *(const v4u*)src;
            float e[8] = {bf_lo(x.x), bf_hi(x.x), bf_lo(x.y), bf_hi(x.y), bf_lo(x.z), bf_hi(x.z), bf_lo(x.w), bf_hi(x.w)};
            if (hh < 20) {
                float ss = 0.f;
#pragma unroll
                for (int j = 0; j < 8; ++j) ss += e[j] * e[j];
                ss += __shfl_xor(ss, 1); ss += __shfl_xor(ss, 2); ss += __shfl_xor(ss, 4);
                const float r = 1.0f / sqrtf(ss * (1.f / 64.f) + EPS); const float* gg = (hh < 16 ? gq : gk) + d0;
#pragma unroll
                for (int j = 0; j < 8; ++j) e[j] = e[j] * r * gg[j];
            }
            float pe[8];
#pragma unroll
            for (int j = 0; j < 8; ++j) pe[j] = __shfl_xor(e[j], 2);
            if (lat && hh < 20) {
                const float sgn = (sub & 2) ? 1.0f : -1.0f;
#pragma unroll
                for (int j = 0; j < 8; ++j) { const float c = rp[2 * j], s = rp[2 * j + 1]; e[j] = e[j] * c + sgn * pe[j] * s; }
            }
            if (hh < 16) {
#pragma unroll
                for (int j = 0; j < 8; ++j) e[j] *= attn_body::C2;
                v4u o; o.x = pk2(e[0], e[1]); o.y = pk2(e[2], e[3]); o.z = pk2(e[4], e[5]); o.w = pk2(e[6], e[7]); *(v4u*)src = o;
            } else if (hh < 20) {
                v4u o; o.x = pk2(e[0], e[1]); o.y = pk2(e[2], e[3]); o.z = pk2(e[4], e[5]); o.w = pk2(e[6], e[7]);
                if (lat) *(v4u*)(Kcat + ((size_t)bb * 4352 + 256 + tl) * 256 + (hh - 16) * 64 + d0) = o;
                else { *(v4u*)src = o; float* ko = kout + ((size_t)((m >> 8) * 2) * 256 + (m & 255)) * 256 + (hh - 16) * 64 + d0; *(f32x4*)ko = (f32x4){e[0], e[1], e[2], e[3]}; *(f32x4*)(ko + 4) = (f32x4){e[4], e[5], e[6], e[7]}; }
            } else if (lat) {
                *(v4u*)(Vcat + ((size_t)bb * 4352 + 256 + tl) * 256 + (hh - 20) * 64 + d0) = x;
            }
        }
    }
}
__device__ __forceinline__ void attn_even(const bf16* P, const bf16* CTX, bf16* A2, const float* rpb, char* lds, int vcu, int G) {
    typedef attn_body::bf16 ab;
    for (int u = vcu; u < 512 + 128; u += G) {
        attn_body::AttnUnitArgs A;
        if (u < 512) {
            const int b = u >> 7, h = (u >> 4) & 7, qb = u & 15; const size_t row0 = TC + (size_t)b * 4096;
            const int r0 = 4 * qb; int k0 = r0 - 4; k0 = k0 < 0 ? 0 : k0; k0 = k0 > 53 ? 53 : k0;
            A.Q = (const ab*)(P + (row0 + qb * 256) * 2048 + 512 + h * 64); A.qp = 2048;
            A.K0 = (const ab*)(CTX + (size_t)(b * 256) * 2048 + 1024 + h * 64); A.V0 = A.K0 + 512;
            A.K1 = (const ab*)(P + (row0 + k0 * 64) * 2048 + 1024 + h * 64); A.V1 = A.K1 + 512; A.kp = 2048; A.tsplit = 4; A.tmax = 10; A.NT = 16;
            A.O = (ab*)(A2 + (row0 + qb * 256) * 1024 + 512 + h * 64); A.op = 1024; A.r0 = r0; A.krow0 = k0; A.rpb = rpb + h * 465;
            attn_body::attn_unit<1, 8>(A, lds);
        } else {
            const int v = u - 512, b = v >> 3, h = v & 7; const size_t row0 = (size_t)b * 256;
            A.Q = (const ab*)(P + row0 * 2048 + 512 + h * 64); A.qp = 2048;
            A.K1 = (const ab*)(P + row0 * 2048 + 1024 + h * 64); A.V1 = A.K1 + 512; A.K0 = A.K1; A.V0 = A.V1; A.kp = 2048; A.tsplit = 0; A.tmax = 3; A.NT = 4;
            A.O = (ab*)(A2 + row0 * 1024 + 512 + h * 64); A.op = 1024; A.r0 = 0; A.krow0 = 0; A.rpb = rpb;
            attn_body::attn_unit<0, 8>(A, lds);
        }
    }
}
__device__ __forceinline__ void attn_odd(const bf16* P, const bf16* Kcat, const bf16* Vcat, bf16* A2, char* lds, int vcu, int G) {
    typedef attn_body::bf16 ab;
    for (int u = vcu; u < 1024 + 256; u += G) {
        attn_body::AttnUnitArgs A; A.tsplit = 0; A.r0 = 0; A.krow0 = 0; A.rpb = nullptr; A.qp = 1536; A.op = 1024;
        if (u < 1024) {
            const int b = u >> 8, kvh = (u >> 6) & 3, h4 = (u >> 4) & 3, qb = u & 15, hq = kvh * 4 + h4; const size_t row0 = TC + (size_t)b * 4096 + qb * 256;
            A.Q = (const ab*)(P + row0 * 1536 + hq * 64);
            A.K1 = (const ab*)(Kcat + (size_t)b * 4352 * 256 + kvh * 64); A.V1 = (const ab*)(Vcat + (size_t)b * 4352 * 256 + kvh * 64); A.kp = 256; A.tmax = 67; A.NT = 68;
            A.O = (ab*)(A2 + row0 * 1024 + hq * 64);
        } else {
            const int v = u - 1024, b = v >> 4, hq = v & 15, kvh = hq >> 2; const size_t row0 = (size_t)b * 256;
            A.Q = (const ab*)(P + row0 * 1536 + hq * 64);
            A.K1 = (const ab*)(P + row0 * 1536 + 1024 + kvh * 64); A.V1 = A.K1 + 256; A.kp = 1536; A.tmax = 3; A.NT = 4;
            A.O = (ab*)(A2 + row0 * 1024 + hq * 64);
        }
        A.K0 = A.K1; A.V0 = A.V1;
        attn_body::attn_unit<0, 8>(A, lds);
    }
}

#ifndef PH_LIMIT
#define PH_LIMIT 100000
#endif
#define PROBE_UP2 0
#define PROBE_SYNC2 0
#define PROBE_ATTN2 0
#define PROBE_NORM2 0
__global__ void __launch_bounds__(NWAVES * 64, 2) mega_fwd(Args args_unused) {
    extern __shared__ __attribute__((aligned(16))) unsigned char lds[];
    cg::grid_group grid = cg::this_grid();
    int nph = 0;
#define KA() ({ KArgs p_ = (KArgs)__builtin_amdgcn_kernarg_segment_ptr(); asm volatile("" : "+s"(p_)); p_; })
#define IDS() const int tid = tid_now(), lane = tid & 63, wave = __builtin_amdgcn_readfirstlane(tid >> 6); const int G = sgpr_now(gridDim.x), bx = sgpr_now(blockIdx.x), vcu = (G % 8 == 0) ? (bx % 8) * (G / 8) + bx / 8 : bx; (void)tid; (void)lane; (void)wave; (void)vcu
#define XBAR() do { XcdBarrier b_; b_.bar = (unsigned*)(KA()->ws + WS_CTL) + CW_BAR; b_.x = xb_xcc_id(); b_.st = (volatile LAS unsigned*)((LAS unsigned char*)lds + MISC_OFF) + 8; xcd_barrier(b_); } while (0)
#define SYNC() do { XBAR(); if (PROBE_SYNC2) XBAR(); if (++nph >= PH_LIMIT) return; } while (0)
    for (int u = threadIdx.x; u < (LDS_BYTES - LDSCTL_OFF) / 4; u += NWAVES * 64) ((LAS unsigned*)((LAS unsigned char*)lds + LDSCTL_OFF))[u] = 0u;
    __syncthreads();
    (void)xcd_barrier_post((unsigned*)(KA()->ws + WS_CTL) + CW_BAR, (volatile LAS unsigned*)((LAS unsigned char*)lds + MISC_OFF) + 8);

    { IDS(); prologue_a(KA(), (LAS unsigned char*)lds, vcu, G, wave, lane); }
    if (KA()->ws == nullptr) grid.sync();
    SYNC();
    { IDS(); prologue_b(KA(), vcu, G, tid); }
    SYNC();

#pragma unroll 1
    for (int ls = 0; ls < 12; ++ls) {
        const int l = ls / 3, sub = ls - 3 * l;
        const bool fusedn = (sgpr_now(gridDim.x) == 256);
        if (ls == 0 || !fusedn) {
            IDS(); KArgs a = KA(); unsigned char* ws = a->ws; const bool first = (ls == 0);
            const float* X = (const float*)(ws + WS_X);
            if (first) norm_phase<false>(a->in[I_XP], a->in[I_XS] - (size_t)TC * D, a->in[I_GNORM] + ls * 1024, (const float*)(ws + WS_MOD) + (size_t)l * 5 * 9216, 3 * sub, 3 * sub + 1, (bf16*)(ws + WS_H), (_Float16*)(ws + WS_X), vcu, G, wave, lane);
            else norm_phase<true>(X, X, a->in[I_GNORM] + ls * 1024, (const float*)(ws + WS_MOD) + (size_t)l * 5 * 9216, 3 * sub, 3 * sub + 1, (bf16*)(ws + WS_H), nullptr, vcu, G, wave, lane);
            SYNC();
        }
        if (sub != 1) {
            {
                KArgs a = KA(); unsigned char* ws = a->ws; const int mat = l * 2 + (sub >> 1);
                pg8::Gemm g{(const bf16*)(ws + WS_H), (const bf16*)(ws + WS_WFI) + (size_t)mat * NFF * 1024, T, NFF, D}; pg8::StaticOrder S; S.init(T, NFF, D, sgpr_now(gridDim.x), sgpr_now(blockIdx.x));
                pg8::EpiSwiGLU E{(bf16*)(ws + WS_U), DFF / FFO_KS, DFF / FFO_KS, (size_t)T * (DFF / FFO_KS)};
                pg8::gemm_phase<pg8::EpiSwiGLU, pg8::StaticOrder, true, true>((LAS unsigned char*)lds + RING_OFF, g, S, E);
                if (PROBE_UP2) { grid.sync(); pg8::gemm_phase<pg8::EpiSwiGLU, pg8::StaticOrder, true, true>((LAS unsigned char*)lds + RING_OFF, g, S, E); }
            }
            SYNC();
            {
                KArgs a = KA(); unsigned char* ws = a->ws; const int mat = l * 2 + (sub >> 1); const bool first = (ls == 0), last = (ls == 11);
                float* X = (float*)(ws + WS_X);
                pg8::Gemm g{(const bf16*)(ws + WS_U), (const bf16*)(ws + WS_WFO) + (size_t)mat * DFF * 1024, T, D, DFF}; pg8::TailOrder S; S.init(T, D, DFF, sgpr_now(gridDim.x), sgpr_now(blockIdx.x));
                pg8::EpiResid E{ws, last ? a->in[I_GFINAL] : a->in[I_GNORM], a->out, 0.5f, DFF / 64, ls, fusedn ? (last ? 2 : 1) : 0};
                pg8::gemm_phase<pg8::EpiResid, pg8::TailOrder, true, true>((LAS unsigned char*)lds + RING_OFF, g, S, E);
            }
            if (!(fusedn && ls == 11)) SYNC();
        } else {
            const int e = l >> 1; const bool even = !(l & 1);
            if (even) {
                KArgs a = KA(); unsigned char* ws = a->ws; float* out = a->out;
                float* o_nbk = out + (size_t)T * D, *o_nbv = o_nbk + 16 * 2 * 256 * 512;
                pg8::Gemm g{(const bf16*)(ws + WS_H), (const bf16*)(ws + WS_WIAB) + (size_t)e * 2048 * 1024, T, 2048, D}; pg8::StaticOrder S; S.init(T, 2048, D, sgpr_now(gridDim.x), sgpr_now(blockIdx.x));
                pg8::EpiProj E;
                E.O = (bf16*)(ws + WS_U); E.ldc = 2048; E.sc = attn_body::C2;
                E.sc_lo = 2; E.sc_hi = 4; E.fo[0] = o_nbk + (size_t)e * 256 * 512; E.f_lo[0] = 4; E.f_hi[0] = 6; E.fo[1] = o_nbv + (size_t)e * 256 * 512; E.f_lo[1] = 6; E.f_hi[1] = 8; E.fw = 512;
                pg8::gemm_phase<pg8::EpiProj, pg8::StaticOrder, true, true>((LAS unsigned char*)lds + RING_OFF, g, S, E);
            } else {
                KArgs a = KA(); unsigned char* ws = a->ws;
                pg8::Gemm g{(const bf16*)(ws + WS_H), (const bf16*)(ws + WS_WQKV) + (size_t)e * 1536 * 1024, T, 1536, D}; pg8::StaticOrder S; S.init(T, 1536, D, sgpr_now(gridDim.x), sgpr_now(blockIdx.x));
                pg8::EpiQKV E{ws, a->in[I_GQ] + e * 64, a->in[I_GK] + e * 64, a->out + (size_t)T * D + 2 * 16 * 2 * 256 * 512 + (size_t)e * 256 * 256, e};
                pg8::gemm_phase<pg8::EpiQKV, pg8::StaticOrder, true, true>((LAS unsigned char*)lds + RING_OFF, g, S, E);
            }
            SYNC();
            if (even) {
                { IDS(); KArgs a = KA(); unsigned char* ws = a->ws; pool_phase((const bf16*)(ws + WS_U), (bf16*)(ws + WS_A2), vcu, G, wave, lane); }
                { IDS(); KArgs a = KA(); unsigned char* ws = a->ws;
                  attn_even((const bf16*)(ws + WS_U), (const bf16*)(ws + WS_CTXNB) + (size_t)e * 1024 * 2048, (bf16*)(ws + WS_A2), a->in[I_RPB] + (size_t)e * 8 * 465, (char*)lds + RING_OFF, vcu, G); }
            } else {
                { IDS(); KArgs a = KA(); unsigned char* ws = a->ws;
                  attn_odd((const bf16*)(ws + WS_U), (const bf16*)(ws + WS_KCAT) + (size_t)e * KCAT_STRIDE, (const bf16*)(ws + WS_VCAT) + (size_t)e * KCAT_STRIDE, (bf16*)(ws + WS_A2), (char*)lds + RING_OFF, vcu, G); }
            }
            SYNC();
            {
                KArgs a = KA(); unsigned char* ws = a->ws; float* X = (float*)(ws + WS_X);
                pg8::Gemm g{(const bf16*)(ws + WS_A2), even ? (const bf16*)(ws + WS_WOAB) + (size_t)e * 1024 * 1024 : (const bf16*)(ws + WS_WOC) + (size_t)e * 1024 * 1024, T, D, D}; pg8::TailOrder S; S.init(T, D, D, sgpr_now(gridDim.x), sgpr_now(blockIdx.x));
                pg8::EpiResid E{ws, a->in[I_GNORM], a->out, 1.0f, D / 64, ls, fusedn ? 1 : 0};
                pg8::gemm_phase<pg8::EpiResid, pg8::TailOrder, true, true>((LAS unsigned char*)lds + RING_OFF, g, S, E);
            }
            SYNC();
        }
    }
    if (sgpr_now(gridDim.x) != 256) { IDS(); KArgs a = KA(); final_norm((const float*)(a->ws + WS_X), a->in[I_GFINAL], a->out, vcu, G, wave, lane); }
#undef SYNC
}

extern "C" void kernel_launch(void* const* d_in, const int* in_sizes, int n_in, void* d_out, int out_size, void* d_ws, size_t ws_size, hipStream_t stream) {
    static int grid = 0;
    if (grid == 0) {
        if (n_in != 23 || ws_size < WS_END || out_size != 33554432) { fprintf(stderr, "kernel_launch: unexpected shapes: n_in %d out %d ws %zu (need %zu)\n", n_in, out_size, ws_size, (size_t)WS_END); grid = -1; return; }
        int dev = 0, cus = 0, per_cu = 0;
        if (hipGetDevice(&dev) != hipSuccess || hipDeviceGetAttribute(&cus, hipDeviceAttributeMultiprocessorCount, dev) != hipSuccess) { grid = -1; return; }
        if (hipFuncSetAttribute((const void*)mega_fwd, hipFuncAttributeMaxDynamicSharedMemorySize, LDS_BYTES) != hipSuccess) { fprintf(stderr, "kernel_launch: hipFuncSetAttribute failed\n"); grid = -1; return; }
        if (hipOccupancyMaxActiveBlocksPerMultiprocessor(&per_cu, (const void*)mega_fwd, NWAVES * 64, LDS_BYTES) != hipSuccess || per_cu < 1) { fprintf(stderr, "kernel_launch: occupancy query says %d\n", per_cu); per_cu = 1; }
        (void)hipGetLastError();
        grid = cus * per_cu;
    }
    if (grid < 0) return;
    if (hipMemsetAsync((char*)d_ws + WS_CTL, 0, CTL_ZERO_BYTES, stream) != hipSuccess) { fprintf(stderr, "kernel_launch: memset of the barrier words failed\n"); return; }
    Args a{};
    for (int i = 0; i < 23; ++i) a.in[i] = (const float*)d_in[i];
    a.out = (float*)d_out; a.ws = (unsigned char*)d_ws;
    void* params[] = {&a};
    const hipError_t le = hipLaunchCooperativeKernel((const void*)mega_fwd, dim3(grid), dim3(NWAVES * 64), params, LDS_BYTES, stream);
    if (le != hipSuccess) fprintf(stderr, "kernel_launch: cooperative launch failed: %s (grid %d)\n", hipGetErrorName(le), grid);
}
```

```cpp
#include <hip/hip_runtime.h>
#include <hip/hip_cooperative_groups.h>
#include <hip/hip_bf16.h>
#include <cstdio>
#include <cstdint>
#include <cmath>
namespace cg = cooperative_groups;
constexpr int NWAVES = 8;
constexpr int T = 20480, TC = 4096, D = 1024, DFF = 2816, NFF = 5632;
constexpr int FFO_KS = 1;
constexpr int OUT_KS = 1;
constexpr float EPS = 1e-6f;
constexpr size_t MiB = 1u << 20;
constexpr size_t WS_ROWSQ = 1 * MiB  , WS_MOD = 3 * MiB, WS_ROPE = 4 * MiB,
                 WS_WFI = 16 * MiB, WS_WFO = 104 * MiB, WS_WIAB = 148 * MiB, WS_WOAB = 156 * MiB, WS_WQKV = 160 * MiB, WS_WOC = 166 * MiB,
                 WS_X = 170 * MiB, WS_H = 250 * MiB, WS_A2 = 290 * MiB, WS_U = 330 * MiB, WS_CTXNB = 440 * MiB, WS_KCAT = 448 * MiB, WS_VCAT = 466 * MiB, WS_MODP = 484 * MiB, WS_PART = 496 * MiB  , WS_END = 560 * MiB;
constexpr size_t KCAT_STRIDE = 9 * MiB / 2;
constexpr int ADA_KC = 16;
constexpr int RING_OFF = 0, RING_BYTES = 131072, LDS_BYTES = 147456;
constexpr size_t WS_CTL = 0, CTL_ZERO_BYTES = 3u << 20; constexpr int CW_BAR = 4096, CW_CNT = 65536, CW_PCNT = 131072;
constexpr int LDSCTL_OFF = 131072, MISC_OFF = LDSCTL_OFF + 320;
__device__ __forceinline__ int tid_now() { int t = threadIdx.x; asm volatile("" : "+v"(t)); return t; }
__device__ __forceinline__ int sgpr_now(int v) { asm volatile("" : "+s"(v)); return v; }
namespace pg8 {
#define PG8_LAS __attribute__((address_space(3)))
typedef unsigned short bf16_t;
typedef short bf16x8 __attribute__((ext_vector_type(8)));
typedef float f32x4 __attribute__((ext_vector_type(4)));
typedef unsigned u32x4 __attribute__((ext_vector_type(4)));
typedef unsigned u32x2 __attribute__((ext_vector_type(2)));
typedef _Float16 h8 __attribute__((ext_vector_type(8)));
constexpr int BM = 256, BK = 64, HALF = 128, HTB = HALF * BK * 2  , STAGE_BYTES = 8 * HTB, NXCD = 8, WGM = 8;

__host__ __device__ __forceinline__ int lds_byte(int r, int c) { const int st = (r >> 4) * 2 + (c >> 5), rr = r & 15, cc = c & 31, ob = rr * 64 + cc * 2; return st * 1024 + (ob ^ (((ob >> 9) & 1) << 5)); }
__host__ __device__ __forceinline__ void stage_rc(int b, int& R, int& C) { const int st = b / 1024, sb = b % 1024, swz = sb ^ (((sb >> 9) & 1) << 5); R = (st >> 1) * 16 + swz / 64; C = (st & 1) * 32 + (swz % 64) / 2; }
__host__ __device__ __forceinline__ int perm32(int rho) { const int n = rho >> 4, i = rho & 15; return 8 * (i >> 2) + 4 * n + (i & 3); }

struct Unit { int pm, pn, k0, nk, slot, ks; };
struct Gemm { const bf16_t* A; const bf16_t* Bt; int M, N, K; };

struct StaticOrder {
    int nM, nN, nwg, G, c, ntf;
    __host__ __device__ void init(int M, int N, int K, int G_, int c_) { nM = M / BM; nN = N / BM; nwg = nM * nN; G = G_; c = c_; ntf = K / BK; }
    __host__ __device__ bool next(int i, Unit& u) const {
        const long L = (long)i * G + c; if (L >= nwg) return false;
        int wgid = (int)L; { const int q = nwg / NXCD, r = nwg % NXCD, xcd = wgid % NXCD, off = wgid / NXCD; wgid = (xcd < r ? xcd * (q + 1) : r * (q + 1) + (xcd - r) * q) + off; }
        const int nig = WGM * nN, gid = wgid / nig, fm = gid * WGM, gsz = (nM - fm) < WGM ? (nM - fm) : WGM;
        u.pm = fm + ((wgid % nig) % gsz); u.pn = (wgid % nig) / gsz; u.k0 = 0; u.nk = ntf; u.slot = 0; u.ks = 0; return true;
    }
    __device__ __forceinline__ void a_ready(const Unit&) const {}
    __device__ __forceinline__ void done(const Unit&) const {}
};

__device__ __forceinline__ unsigned cvt_pk_bf16(float lo, float hi) { unsigned r; asm volatile("v_cvt_pk_bf16_f32 %0, %1, %2" : "=v"(r) : "v"(lo), "v"(hi)); return r; }
__device__ __forceinline__ int ms_of_pm(int pm) { return pm < 16 ? 0 : 1 + ((pm - 16) >> 4); }
__device__ __forceinline__ float silu_f(float a) { return a * __builtin_amdgcn_rcpf(1.0f + __builtin_amdgcn_exp2f(-1.4426950408889634f * a)); }

struct EpiSwiGLU {
    static constexpr bool PERM = true, AFTER_DRAIN = false;
    bf16_t* U; int ldu; int ksplit; size_t split_stride;
    __device__ __forceinline__ void operator()(const f32x4 (&acc)[2][2][4][2], const Unit& u, int wr, int wc, int fr, int fq) const {
        const int row0 = u.pm * BM + wr * 64 + fr; int colt = u.pn * HALF; bf16_t* base = U;
        { const int t = colt / ksplit; base += (size_t)t * split_stride; colt -= t * ksplit; }
        const int col0 = colt + wc * 32 + 8 * fq;
#pragma unroll
        for (int ai = 0; ai < 2; ++ai)
#pragma unroll
            for (int m = 0; m < 4; ++m) { bf16_t* rowp = base + (size_t)(row0 + ai * HALF + m * 16) * ldu + col0;
                const f32x4 a0 = acc[ai][0][m][0], a1 = acc[ai][0][m][1], b0 = acc[ai][1][m][0], b1 = acc[ai][1][m][1];
                u32x4 w; w.x = cvt_pk_bf16(silu_f(a0[0]) * b0[0], silu_f(a0[1]) * b0[1]); w.y = cvt_pk_bf16(silu_f(a0[2]) * b0[2], silu_f(a0[3]) * b0[3]);
                w.z = cvt_pk_bf16(silu_f(a1[0]) * b1[0], silu_f(a1[1]) * b1[1]); w.w = cvt_pk_bf16(silu_f(a1[2]) * b1[2], silu_f(a1[3]) * b1[3]);
                *(u32x4*)rowp = w; }
    }
};
struct EpiResid {
    static constexpr bool PERM = true, AFTER_DRAIN = false;
    unsigned char* ws; const float* gnorm; float* yout; float scale; int ntf, ls, fused;
    __device__ __forceinline__ void operator()(f32x4 (&acc)[2][2][4][2], const Unit& u, int wr, int wc, int fr, int fq) const {
        const int tid = threadIdx.x;
        const int lyr = ls / 3, sub = ls - 3 * lyr, ln = (ls + 1) / 3, subn = (ls + 1) - 3 * ln;
        const float* const gate = (const float*)(ws + WS_MOD) + (size_t)lyr * 5 * 9216 + (3 * sub + 2) * 1024;
        float* const part = (float*)(ws + WS_PART); unsigned* const cnt = (unsigned*)(ws + WS_CTL) + CW_CNT + ls * 1024;
        bf16_t* const Hn = fused ? (bf16_t*)(ws + WS_H) : nullptr; const float* const gn = (fused == 2) ? gnorm : gnorm + (ls + 1) * 1024;
        const float* const modn = (const float*)(ws + WS_MOD) + (size_t)ln * 5 * 9216 + 3 * subn * 1024;
        float* const rsq = (float*)(ws + WS_ROWSQ) + (size_t)(ls + 1) * T; unsigned* const pcnt = (unsigned*)(ws + WS_CTL) + CW_PCNT + ls * 5120;
        __attribute__((address_space(3))) float* const S = (__attribute__((address_space(3))) float*)(LDSCTL_OFF + 2048);
        int lo = 0, hi = 8;
        const bool splitu = (u.nk != ntf);
        if (splitu) {
            const int own_ai = u.ks >> 1; const bool mine = (wr == (u.ks & 1));
            h8* P = (h8*)part + (size_t)(u.slot * 4 + u.ks) * (16 * 512) + tid;
#pragma unroll
            for (int j = 0; j < 16; ++j) if (!(mine && (j >> 3) == own_ai)) { const f32x4 a = acc[j >> 3][(j >> 2) & 1][j & 3][0], b = acc[j >> 3][(j >> 2) & 1][j & 3][1];
                const h8 v = {(_Float16)a[0], (_Float16)a[1], (_Float16)a[2], (_Float16)a[3], (_Float16)b[0], (_Float16)b[1], (_Float16)b[2], (_Float16)b[3]};
                asm volatile("global_store_dwordx4 %0, %1, off sc1\n\ts_nop 1" :: "v"(P + (size_t)j * 512), "v"(v) : "memory"); }
            asm volatile("s_waitcnt vmcnt(0)" ::: "memory");
            __syncthreads();
            if (tid == 0) { unsigned* c = cnt + 16 * u.slot; __hip_atomic_fetch_add(c, 1u, __ATOMIC_RELAXED, __HIP_MEMORY_SCOPE_AGENT);
                unsigned sp = 0; while (__hip_atomic_load(c, __ATOMIC_RELAXED, __HIP_MEMORY_SCOPE_AGENT) < 4u) { __builtin_amdgcn_s_sleep(1); if (++sp > (1u << 22)) break; } }
            __syncthreads();
            if (mine) {
                { const h8* Qa = (const h8*)part + (size_t)(u.slot * 4 + ((u.ks + 1) & 3)) * (16 * 512) + tid; const h8* Qb = (const h8*)part + (size_t)(u.slot * 4 + ((u.ks + 2) & 3)) * (16 * 512) + tid;
#pragma unroll
                  for (int h = 0; h < 2; ++h) if (h == own_ai) { h8 t[16];
#pragma unroll
                      for (int j = 0; j < 8; ++j) { asm volatile("global_load_dwordx4 %0, %1, off sc1" : "=v"(t[j]) : "v"(Qa + (size_t)(h * 8 + j) * 512) : "memory"); asm volatile("global_load_dwordx4 %0, %1, off sc1" : "=v"(t[8 + j]) : "v"(Qb + (size_t)(h * 8 + j) * 512) : "memory"); }
                      asm volatile("s_waitcnt vmcnt(0)" : "+v"(t[0]), "+v"(t[1]), "+v"(t[2]), "+v"(t[3]), "+v"(t[4]), "+v"(t[5]), "+v"(t[6]), "+v"(t[7]), "+v"(t[8]), "+v"(t[9]), "+v"(t[10]), "+v"(t[11]), "+v"(t[12]), "+v"(t[13]), "+v"(t[14]), "+v"(t[15]) :: "memory");
#pragma unroll
                      for (int j = 0; j < 8; ++j) { const h8 va = t[j], vb = t[8 + j];
                          acc[h][(j >> 2) & 1][j & 3][0] += (f32x4){(float)va[0], (float)va[1], (float)va[2], (float)va[3]} + (f32x4){(float)vb[0], (float)vb[1], (float)vb[2], (float)vb[3]};
                          acc[h][(j >> 2) & 1][j & 3][1] += (f32x4){(float)va[4], (float)va[5], (float)va[6], (float)va[7]} + (f32x4){(float)vb[4], (float)vb[5], (float)vb[6], (float)vb[7]}; } } }
                { const h8* Q = (const h8*)part + (size_t)(u.slot * 4 + ((u.ks + 3) & 3)) * (16 * 512) + tid;
#pragma unroll
                  for (int h = 0; h < 2; ++h) if (h == own_ai) { h8 t[8];
#pragma unroll
                      for (int j = 0; j < 8; ++j) asm volatile("global_load_dwordx4 %0, %1, off sc1" : "=v"(t[j]) : "v"(Q + (size_t)(h * 8 + j) * 512) : "memory");
                      asm volatile("s_waitcnt vmcnt(0)" : "+v"(t[0]), "+v"(t[1]), "+v"(t[2]), "+v"(t[3]), "+v"(t[4]), "+v"(t[5]), "+v"(t[6]), "+v"(t[7]) :: "memory");
#pragma unroll
                      for (int j = 0; j < 8; ++j) { const h8 v = t[j];
                          acc[h][(j >> 2) & 1][j & 3][0] += (f32x4){(float)v[0], (float)v[1], (float)v[2], (float)v[3]}; acc[h][(j >> 2) & 1][j & 3][1] += (f32x4){(float)v[4], (float)v[5], (float)v[6], (float)v[7]}; } } }
                lo = 4 * own_ai; hi = lo + 4;
            } else { lo = 0; hi = 0; }
        }
        const int pm = u.pm, pn = u.pn; const int ms = ms_of_pm(pm);
        const int col0 = pn * BM + wc * 32 + 8 * fq;
        {
            const float* g = gate + ms * 9216;
            f32x4 gv[2][2];
#pragma unroll
            for (int bj = 0; bj < 2; ++bj)
#pragma unroll
                for (int n = 0; n < 2; ++n) gv[bj][n] = *(const f32x4*)(g + col0 + bj * HALF + n * 4) * scale;
            const size_t off0 = (size_t)(pm * BM + wr * 64 + fr) * 1024 + col0;
            const _Float16* const Xh = (const _Float16*)(ws + WS_X);
#define PG8_FIN_ROWGROUP(H_, M_, B00, B01, B10, B11) do { float ss = 0.f; \
                { const f32x4 x = (B00) + gv[0][0] * acc[H_][0][M_][0]; acc[H_][0][M_][0] = x; ss += (x[0] * x[0] + x[1] * x[1]) + (x[2] * x[2] + x[3] * x[3]); } \
                { const f32x4 x = (B01) + gv[0][1] * acc[H_][0][M_][1]; acc[H_][0][M_][1] = x; ss += (x[0] * x[0] + x[1] * x[1]) + (x[2] * x[2] + x[3] * x[3]); } \
                { const f32x4 x = (B10) + gv[1][0] * acc[H_][1][M_][0]; acc[H_][1][M_][0] = x; ss += (x[0] * x[0] + x[1] * x[1]) + (x[2] * x[2] + x[3] * x[3]); } \
                { const f32x4 x = (B11) + gv[1][1] * acc[H_][1][M_][1]; acc[H_][1][M_][1] = x; ss += (x[0] * x[0] + x[1] * x[1]) + (x[2] * x[2] + x[3] * x[3]); } \
                if (Hn) { ss += __shfl_xor(ss, 16); ss += __shfl_xor(ss, 32); if (fq == 0) S[((H_) * HALF + wr * 64 + (M_) * 16 + fr) * 4 + wc] = ss; } } while (0)
            {
                h8 lh[8][2];
#pragma unroll
                for (int i = 0; i < 8; ++i) if (i >= lo && i < hi) {
#pragma unroll
                    for (int bj = 0; bj < 2; ++bj) lh[i][bj] = *(const h8*)(Xh + off0 + (size_t)((i >> 2) * HALF + (i & 3) * 16) * 1024 + bj * HALF); }
                asm volatile("" ::: "memory");
#pragma unroll
                for (int h = 0; h < 2; ++h)
#pragma unroll
                    for (int m = 0; m < 4; ++m) if (4 * h + m >= lo && 4 * h + m < hi) { const h8 v0 = lh[4 * h + m][0], v1 = lh[4 * h + m][1];
                        PG8_FIN_ROWGROUP(h, m, ((f32x4){(float)v0[0], (float)v0[1], (float)v0[2], (float)v0[3]}), ((f32x4){(float)v0[4], (float)v0[5], (float)v0[6], (float)v0[7]}),
                                               ((f32x4){(float)v1[0], (float)v1[1], (float)v1[2], (float)v1[3]}), ((f32x4){(float)v1[4], (float)v1[5], (float)v1[6], (float)v1[7]})); }
                asm volatile("" ::: "memory");
            }
#undef PG8_FIN_ROWGROUP
            if (fused != 2) {
                _Float16* const Xo = (_Float16*)(ws + WS_X);
#pragma unroll
                for (int h = 0; h < 2; ++h) {
                    size_t offh = off0 + (size_t)(h * HALF) * 1024; asm volatile("" : "+v"(offh));
#pragma unroll
                    for (int m = 0; m < 4; ++m) if (4 * h + m >= lo && 4 * h + m < hi) {
#pragma unroll
                        for (int bj = 0; bj < 2; ++bj) { const f32x4 a = acc[h][bj][m][0], b = acc[h][bj][m][1];
                            const h8 o = {(_Float16)a[0], (_Float16)a[1], (_Float16)a[2], (_Float16)a[3], (_Float16)b[0], (_Float16)b[1], (_Float16)b[2], (_Float16)b[3]};
                            *(h8*)(Xo + offh + (size_t)(m * 16) * 1024 + bj * HALF) = o; } }
                }
            }
        }
        if (!Hn) return;
        const int rb = splitu ? (u.ks >> 1) * HALF + (u.ks & 1) * 64 : 0, nr = splitu ? 64 : BM;
        __syncthreads();
        if (tid < nr) { const int rl = rb + tid; const float tot = (S[rl * 4 + 0] + S[rl * 4 + 1]) + (S[rl * 4 + 2] + S[rl * 4 + 3]); unsafeAtomicAdd(rsq + pm * BM + rl, tot); }
        asm volatile("s_waitcnt vmcnt(0)" ::: "memory");
        __syncthreads();
        if (tid == 0) { unsigned* c = pcnt + 16 * (pm * 4 + (splitu ? u.ks : 0)); __hip_atomic_fetch_add(c, 1u, __ATOMIC_RELAXED, __HIP_MEMORY_SCOPE_AGENT);
            unsigned sp = 0; while (__hip_atomic_load(c, __ATOMIC_RELAXED, __HIP_MEMORY_SCOPE_AGENT) < 4u) { __builtin_amdgcn_s_sleep(1); if (++sp > (1u << 22)) break; } }
        __syncthreads();
        if (hi == 0) return;
        float rr[8];
#pragma unroll
        for (int i = 0; i < 8; ++i) { rr[i] = 0.f; if (i >= lo && i < hi) { const float v = __hip_atomic_load(rsq + pm * BM + (i >> 2) * HALF + wr * 64 + (i & 3) * 16 + fr, __ATOMIC_RELAXED, __HIP_MEMORY_SCOPE_AGENT); rr[i] = __builtin_amdgcn_rsqf(v * (1.0f / 1024.0f) + 1e-6f); } }
        const float* shp = modn + ms * 9216 + col0; const float* gp = gn + col0;
#pragma unroll
        for (int bj = 0; bj < 2; ++bj) { const int co = bj * HALF;
            const size_t o0 = (size_t)(pm * BM + wr * 64 + fr) * 1024 + col0 + co;
            if (fused == 2) {
                const f32x4 gs0 = *(const f32x4*)(gp + co), gs1 = *(const f32x4*)(gp + co + 4);
#pragma unroll
                for (int i = 0; i < 8; ++i) if (i >= lo && i < hi) { float* yp = yout + o0 + (size_t)((i >> 2) * HALF + (i & 3) * 16) * 1024;
                    *(f32x4*)yp = (acc[i >> 2][bj][i & 3][0] * rr[i]) * gs0; *(f32x4*)(yp + 4) = (acc[i >> 2][bj][i & 3][1] * rr[i]) * gs1; }
            } else {
                const f32x4 gs0 = *(const f32x4*)(gp + co) * (*(const f32x4*)(shp + 1024 + co) + 1.0f), gs1 = *(const f32x4*)(gp + co + 4) * (*(const f32x4*)(shp + 1024 + co + 4) + 1.0f);
                const f32x4 sh0 = *(const f32x4*)(shp + co), sh1 = *(const f32x4*)(shp + co + 4);
#pragma unroll
                for (int i = 0; i < 8; ++i) if (i >= lo && i < hi) { const f32x4 y0 = (acc[i >> 2][bj][i & 3][0] * rr[i]) * gs0 + sh0, y1 = (acc[i >> 2][bj][i & 3][1] * rr[i]) * gs1 + sh1;
                    u32x4 w; w.x = cvt_pk_bf16(y0[0], y0[1]); w.y = cvt_pk_bf16(y0[2], y0[3]); w.z = cvt_pk_bf16(y1[0], y1[1]); w.w = cvt_pk_bf16(y1[2], y1[3]);
                    *(u32x4*)(Hn + o0 + (size_t)((i >> 2) * HALF + (i & 3) * 16) * 1024) = w; }
            } }
    }
};
struct EpiProj {
    static constexpr bool PERM = true, AFTER_DRAIN = false;
    bf16_t* O; int ldc; int sc_lo, sc_hi; float sc; float* fo[2]; int f_lo[2], f_hi[2]; int fw;
    __device__ __forceinline__ void operator()(const f32x4 (&acc)[2][2][4][2], const Unit& u, int wr, int wc, int fr, int fq) const {
        const int row0 = u.pm * BM + wr * 64 + fr; const int col0 = u.pn * BM + wc * 32 + 8 * fq;
        const float s = (u.pn >= sc_lo && u.pn < sc_hi) ? sc : 1.0f;
        float* fdst = nullptr;
        if (u.pm < 16) {
#pragma unroll
            for (int i = 0; i < 2; ++i) if (u.pn >= f_lo[i] && u.pn < f_hi[i]) fdst = fo[i] + (size_t)(u.pm * 512 + wr * 64 + fr) * fw + (col0 - 256 * f_lo[i]);
        }
#pragma unroll
        for (int ai = 0; ai < 2; ++ai)
#pragma unroll
            for (int m = 0; m < 4; ++m) { bf16_t* rowp = O + (size_t)(row0 + ai * HALF + m * 16) * ldc + col0;
#pragma unroll
                for (int bj = 0; bj < 2; ++bj) { const f32x4 v0 = acc[ai][bj][m][0] * s, v1 = acc[ai][bj][m][1] * s;
                    u32x4 w; w.x = cvt_pk_bf16(v0[0], v0[1]); w.y = cvt_pk_bf16(v0[2], v0[3]); w.z = cvt_pk_bf16(v1[0], v1[1]); w.w = cvt_pk_bf16(v1[2], v1[3]);
                    *(u32x4*)(rowp + bj * HALF) = w;
                    if (fdst) { float* fp = fdst + (size_t)(ai * HALF + m * 16) * fw + bj * HALF; *(f32x4*)fp = acc[ai][bj][m][0]; *(f32x4*)(fp + 4) = acc[ai][bj][m][1]; } } }
    }
};
struct EpiQKV {
    static constexpr bool PERM = true, AFTER_DRAIN = false;
    unsigned char* ws; const float* gq; const float* gk; float* okv; int e;
    __device__ __forceinline__ void operator()(const f32x4 (&acc)[2][2][4][2], const Unit& u, int wr_, int wc_, int fr_, int fq_) const {
        const int t_ = tid_now(), wid_ = t_ >> 6, wr = wid_ >> 2, wc = wid_ & 3, fr = t_ & 15, fq = (t_ & 63) >> 4; (void)wr_; (void)wc_; (void)fr_; (void)fq_;
        constexpr float c2 = 0.125f * 1.4426950408889634f;
        bf16_t* const O = (bf16_t*)(ws + WS_U); const float* const rope = (const float*)(ws + WS_ROPE);
        bf16_t* const Kc = (bf16_t*)(ws + WS_KCAT) + (size_t)e * KCAT_STRIDE; bf16_t* const Vc = (bf16_t*)(ws + WS_VCAT) + (size_t)e * KCAT_STRIDE;
        __attribute__((address_space(3))) float* const S2 = (__attribute__((address_space(3))) float*)(LDSCTL_OFF + 2048);
        const int pn = u.pn, pm = u.pm; const bool lat = pm >= 16, normed = pn <= 4;
        const int rl0 = wr * 64 + fr, dloc = (wc & 1) * 32 + 8 * fq;
        if (normed) {
#pragma unroll
            for (int ai = 0; ai < 2; ++ai)
#pragma unroll
                for (int m = 0; m < 4; ++m)
#pragma unroll
                    for (int bj = 0; bj < 2; ++bj) { const f32x4 x0 = acc[ai][bj][m][0], x1 = acc[ai][bj][m][1];
                        float ss = ((x0[0] * x0[0] + x0[1] * x0[1]) + (x0[2] * x0[2] + x0[3] * x0[3])) + ((x1[0] * x1[0] + x1[1] * x1[1]) + (x1[2] * x1[2] + x1[3] * x1[3]));
                        ss += __shfl_xor(ss, 16); ss += __shfl_xor(ss, 32);
                        if (fq == 0) S2[((ai * HALF + m * 16 + rl0) * 2 + bj) * 4 + wc] = ss; }
            __syncthreads();
        }
        f32x4 g0 = {1.f, 1.f, 1.f, 1.f}, g1 = g0;
        if (normed) { const float* gg = (pn < 4 ? gq : gk) + dloc; g0 = *(const f32x4*)gg; g1 = *(const f32x4*)(gg + 4); }
        const float sgn = (fq & 2) ? 1.0f : -1.0f, qs = (pn < 4) ? c2 : 1.0f;
#pragma unroll
        for (int ai = 0; ai < 2; ++ai)
#pragma unroll
            for (int m = 0; m < 4; ++m) {
                asm volatile("" ::: "memory");
                const int rl = ai * HALF + m * 16 + rl0; const int row = pm * BM + rl; const int tl = (row - 4096) & 4095, bb = (row - 4096) >> 12;
                f32x4 c0 = {1.f, 0.f, 1.f, 0.f}, c1 = c0, c2v = c0, c3 = c0;
                if (lat && normed) { const int pos = (wc & 1) ? (tl & 63) : (tl >> 6); const float* rp = rope + (pos * 16 + 8 * (fq & 1)) * 2;
                    c0 = *(const f32x4*)rp; c1 = *(const f32x4*)(rp + 4); c2v = *(const f32x4*)(rp + 8); c3 = *(const f32x4*)(rp + 12); }
#pragma unroll
                for (int bj = 0; bj < 2; ++bj) {
                    f32x4 x0 = acc[ai][bj][m][0], x1 = acc[ai][bj][m][1];
                    if (normed) {
                        const float ss = S2[(rl * 2 + bj) * 4 + wc] + S2[(rl * 2 + bj) * 4 + (wc ^ 1)]; const float r = __builtin_amdgcn_rsqf(ss * (1.0f / 64.0f) + 1e-6f);
                        x0 = x0 * r * g0; x1 = x1 * r * g1;
                        if (lat) { f32x4 p0, p1;
#pragma unroll
                            for (int t = 0; t < 4; ++t) { p0[t] = __shfl_xor(x0[t], 32); p1[t] = __shfl_xor(x1[t], 32); }
                            x0 = (f32x4){x0[0] * c0[0] + sgn * p0[0] * c0[1], x0[1] * c0[2] + sgn * p0[1] * c0[3], x0[2] * c1[0] + sgn * p0[2] * c1[1], x0[3] * c1[2] + sgn * p0[3] * c1[3]};
                            x1 = (f32x4){x1[0] * c2v[0] + sgn * p1[0] * c2v[1], x1[1] * c2v[2] + sgn * p1[1] * c2v[3], x1[2] * c3[0] + sgn * p1[2] * c3[1], x1[3] * c3[2] + sgn * p1[3] * c3[3]}; }
                    }
                    const f32x4 y0 = x0 * qs, y1 = x1 * qs;
                    u32x4 w; w.x = cvt_pk_bf16(y0[0], y0[1]); w.y = cvt_pk_bf16(y0[2], y0[3]); w.z = cvt_pk_bf16(y1[0], y1[1]); w.w = cvt_pk_bf16(y1[2], y1[3]);
                    const int hcol = (bj * 2 + (wc >> 1)) * 64 + dloc;
                    if (pn < 4 || !lat) *(u32x4*)(O + (size_t)row * 1536 + pn * BM + hcol) = w;
                    else *(u32x4*)((pn == 4 ? Kc : Vc) + ((size_t)bb * 4352 + 256 + tl) * 256 + hcol) = w;
                    if (pn >= 4 && !lat) { float* fp = okv + (pn == 5 ? 16 * 2 * 256 * 256 : 0) + ((size_t)(pm * 2) * 256 + rl) * 256 + hcol; *(f32x4*)fp = x0; *(f32x4*)(fp + 4) = x1; }
                }
            }
    }
};
struct TailOrder {
    int nM, nN, nwg, G, c, ntf; bool split;
    __host__ __device__ void init(int M, int N, int K, int G_, int c_) { nM = M / BM; nN = N / BM; nwg = nM * nN; G = G_; c = c_; ntf = K / BK; split = (G == 256 && nM == 80 && nN == 4 && ntf >= 16); }
    __host__ __device__ bool next(int i, Unit& u) const {
        if (split) {
            const int x = c & 7, j = c >> 3;
            if (i == 0) { u.pm = 8 * x + (j & 7); u.pn = j >> 3; u.k0 = 0; u.nk = ntf; u.slot = 0; u.ks = 0; return true; }
            if (i == 1) { const int t8 = j >> 2, q = j & 3; u.pm = 64 + 2 * x + (t8 >> 2); u.pn = t8 & 3;
                const int pairs = ntf >> 1, pq = pairs >> 2, rem = pairs & 3; u.k0 = 2 * (q * pq + (q < rem ? q : rem)); u.nk = 2 * (pq + (q < rem ? 1 : 0)); u.slot = x * 8 + t8; u.ks = q; return true; }
            return false;
        }
        const long L = (long)i * G + c; if (L >= nwg) return false;
        int wgid = (int)L; { const int qq = nwg / NXCD, r = nwg % NXCD, xcd = wgid % NXCD, off = wgid / NXCD; wgid = (xcd < r ? xcd * (qq + 1) : r * (qq + 1) + (xcd - r) * qq) + off; }
        const int nig = WGM * nN, gid = wgid / nig, fm = gid * WGM, gsz = (nM - fm) < WGM ? (nM - fm) : WGM;
        u.pm = fm + ((wgid % nig) % gsz); u.pn = (wgid % nig) / gsz; u.k0 = 0; u.nk = ntf; u.slot = 0; u.ks = 0;
        return true;
    }
    __device__ __forceinline__ void a_ready(const Unit&) const {}
    __device__ __forceinline__ void done(const Unit&) const {}
};

template <class Epi, class Sched, bool ALIGN_EPI = false, bool SP2 = false>
__device__ __forceinline__ void gemm_phase(PG8_LAS unsigned char* lds, const Gemm g, const Sched& S, const Epi& E) {
    const int tid = tid_now(), wid = __builtin_amdgcn_readfirstlane(tid >> 6), lane = tid & 63, wr = wid >> 2, wc = wid & 3, fr = lane & 15, fq = lane >> 4;
    const int K = g.K;
    unsigned voffA[2], voffB[2];
#pragma unroll
    for (int i = 0; i < 2; ++i) { int R, C; stage_rc(tid * 16 + i * 8192, R, C); const int Rb = Epi::PERM ? ((R & ~31) + perm32(R & 31)) : R;
        voffA[i] = (unsigned)(R * K + C) * 2u; voffB[i] = (unsigned)(Rb * K + C) * 2u; }
    const size_t kstep = (size_t)(BK * 2);
    const size_t hstep = (size_t)HALF * K * 2;
    const size_t tstep = 2 * hstep;
    const unsigned ldsw = (unsigned)wid * 1024u;
    const int aoff = lds_byte(wr * 64 + fr, fq * 8), boff = lds_byte(wc * 32 + fr, fq * 8);
#define PG8_SA(b, h) (((b) * 2 + (h)) * HTB)
#define PG8_SB(b, h) ((4 + (b) * 2 + (h)) * HTB)
#define PG8_STAGE(bufoff, gbase, voff) do { _Pragma("unroll") for (int _i = 0; _i < 2; ++_i) \
        __builtin_amdgcn_global_load_lds((const unsigned*)((const char*)(gbase) + (voff)[_i]), (PG8_LAS unsigned*)(lds + (bufoff) + ldsw + _i * 8192), 16, 0, 0); } while (0)
#define PG8_LDA(dst, b, h) do { _Pragma("unroll") for (int m = 0; m < 4; ++m) _Pragma("unroll") for (int k = 0; k < 2; ++k) dst[m][k] = *(const PG8_LAS bf16x8*)(lds + PG8_SA(b, h) + aoff + m * 2048 + k * 1024); } while (0)
#define PG8_LDB(dst, b, h) do { _Pragma("unroll") for (int n = 0; n < 2; ++n) _Pragma("unroll") for (int k = 0; k < 2; ++k) dst[n][k] = *(const PG8_LAS bf16x8*)(lds + PG8_SB(b, h) + boff + n * 2048 + k * 1024); } while (0)
#define PG8_MMA(ai, bj, At, Bt) do { __builtin_amdgcn_s_setprio(1); _Pragma("unroll") for (int m = 0; m < 4; ++m) _Pragma("unroll") for (int n = 0; n < 2; ++n) _Pragma("unroll") for (int k = 0; k < 2; ++k) \
        acc[ai][bj][m][n] = __builtin_amdgcn_mfma_f32_16x16x32_bf16(Bt[n][k], At[m][k], acc[ai][bj][m][n], 0, 0, 0); __builtin_amdgcn_s_setprio(0); } while (0)
#define PG8_WAIT_V(n) asm volatile("s_waitcnt vmcnt(" #n ")" ::: "memory")
#define PG8_WAIT_L(n) asm volatile("s_waitcnt lgkmcnt(" #n ")" ::: "memory")
#define PG8_BAR __builtin_amdgcn_s_barrier()
#define PG8_SCHED __builtin_amdgcn_sched_barrier(0)
    Unit cur, nxt; int ui = 0;
    if (!S.next(0, cur)) return;
    f32x4 acc[2][2][4][2];
#pragma unroll
    for (int a = 0; a < 2; ++a)
#pragma unroll
        for (int b = 0; b < 2; ++b)
#pragma unroll
            for (int m = 0; m < 4; ++m)
#pragma unroll
                for (int n = 0; n < 2; ++n) acc[a][b][m][n] = (f32x4){0.f, 0.f, 0.f, 0.f};
    bf16x8 At[4][2], B0[2][2], B1[2][2];
    const char* cA = (const char*)g.A + (size_t)cur.pm * tstep + (size_t)cur.k0 * kstep; const char* cB = (const char*)g.Bt + (size_t)cur.pn * tstep + (size_t)cur.k0 * kstep;
    S.a_ready(cur);
    if constexpr (SP2) {
        PG8_STAGE(PG8_SB(0, 0), cB, voffB); PG8_STAGE(PG8_SB(0, 1), cB + hstep, voffB); PG8_STAGE(PG8_SA(0, 0), cA, voffA); PG8_STAGE(PG8_SA(0, 1), cA + hstep, voffA);
        if (wr == 1) PG8_BAR;
        PG8_WAIT_V(2); PG8_BAR;
        PG8_STAGE(PG8_SB(1, 0), cB + kstep, voffB); PG8_STAGE(PG8_SA(1, 0), cA + kstep, voffA); PG8_STAGE(PG8_SB(1, 1), cB + hstep + kstep, voffB);
        PG8_WAIT_V(6); PG8_BAR;
    } else {
        PG8_STAGE(PG8_SB(0, 0), cB, voffB); PG8_STAGE(PG8_SA(0, 0), cA, voffA); PG8_STAGE(PG8_SB(0, 1), cB + hstep, voffB); PG8_STAGE(PG8_SA(0, 1), cA + hstep, voffA);
        if (wr == 1) PG8_BAR;
        PG8_WAIT_V(4); PG8_BAR;
        PG8_STAGE(PG8_SB(1, 0), cB + kstep, voffB); PG8_STAGE(PG8_SA(1, 0), cA + kstep, voffA); PG8_STAGE(PG8_SB(1, 1), cB + hstep + kstep, voffB);
        PG8_WAIT_V(6); PG8_BAR;
    }
    for (;;) {
        const bool has_next = S.next(ui + 1, nxt);
        const char* nA = has_next ? (const char*)g.A + (size_t)nxt.pm * tstep + (size_t)nxt.k0 * kstep : cA; const char* nB = has_next ? (const char*)g.Bt + (size_t)nxt.pn * tstep + (size_t)nxt.k0 * kstep : cB;
        const int nt = cur.nk;
        for (int t = 0; t < nt; t += 2) {
            const bool last = (t == nt - 2);
            const char* a1 = cA + (size_t)(t + 1) * kstep;
            const char* a2 = last ? nA : cA + (size_t)(t + 2) * kstep; const char* b2 = last ? nB : cB + (size_t)(t + 2) * kstep;
            const char* a3 = a2 + kstep; const char* b3 = b2 + kstep;
            if (last && has_next) S.a_ready(nxt);
            if constexpr (SP2) {
            PG8_LDB(B0, 0, 0); PG8_LDB(B1, 0, 1); PG8_SCHED; PG8_LDA(At, 0, 0); PG8_STAGE(PG8_SA(1, 1), a1 + hstep, voffA);
            PG8_WAIT_V(8); PG8_WAIT_L(0); PG8_BAR; PG8_MMA(0, 0, At, B0); PG8_MMA(0, 1, At, B1); PG8_BAR; PG8_SCHED;
            PG8_LDA(At, 0, 1); PG8_STAGE(PG8_SB(0, 0), b2, voffB); PG8_STAGE(PG8_SB(0, 1), b2 + hstep, voffB); PG8_STAGE(PG8_SA(0, 0), a2, voffA);
            PG8_WAIT_V(8); PG8_WAIT_L(0); PG8_BAR; PG8_MMA(1, 0, At, B0); PG8_MMA(1, 1, At, B1); PG8_BAR; PG8_SCHED;
            PG8_LDB(B0, 1, 0); PG8_LDB(B1, 1, 1); PG8_SCHED; PG8_LDA(At, 1, 0); PG8_STAGE(PG8_SA(0, 1), a2 + hstep, voffA);
            PG8_WAIT_V(8); PG8_WAIT_L(0); PG8_BAR; PG8_MMA(0, 0, At, B0); PG8_MMA(0, 1, At, B1); PG8_BAR; PG8_SCHED;
            PG8_LDA(At, 1, 1); PG8_STAGE(PG8_SB(1, 0), b3, voffB); PG8_STAGE(PG8_SB(1, 1), b3 + hstep, voffB); PG8_STAGE(PG8_SA(1, 0), a3, voffA);
            PG8_WAIT_V(8); PG8_WAIT_L(0); PG8_BAR; PG8_MMA(1, 0, At, B0); PG8_MMA(1, 1, At, B1); PG8_BAR; PG8_SCHED;
            } else {
            PG8_LDB(B0, 0, 0); PG8_SCHED; PG8_LDA(At, 0, 0); PG8_STAGE(PG8_SA(1, 1), a1 + hstep, voffA);
            PG8_WAIT_L(8); PG8_BAR; PG8_WAIT_L(0); PG8_MMA(0, 0, At, B0); PG8_BAR; PG8_SCHED;
            PG8_LDB(B1, 0, 1); PG8_STAGE(PG8_SB(0, 0), b2, voffB);
            PG8_BAR; PG8_WAIT_L(0); PG8_MMA(0, 1, At, B1); PG8_BAR;
            PG8_LDA(At, 0, 1); PG8_STAGE(PG8_SA(0, 0), a2, voffA);
            PG8_BAR; PG8_WAIT_L(0); PG8_MMA(1, 0, At, B0); PG8_BAR; PG8_SCHED;
            PG8_STAGE(PG8_SB(0, 1), b2 + hstep, voffB);
            PG8_WAIT_V(6); PG8_BAR; PG8_MMA(1, 1, At, B1); PG8_BAR;
            PG8_LDB(B0, 1, 0); PG8_SCHED; PG8_LDA(At, 1, 0); PG8_STAGE(PG8_SA(0, 1), a2 + hstep, voffA);
            PG8_WAIT_L(8); PG8_BAR; PG8_WAIT_L(0); PG8_MMA(0, 0, At, B0); PG8_BAR; PG8_SCHED;
            PG8_LDB(B1, 1, 1); PG8_STAGE(PG8_SB(1, 0), b3, voffB);
            PG8_BAR; PG8_WAIT_L(0); PG8_MMA(0, 1, At, B1); PG8_BAR;
            PG8_LDA(At, 1, 1); PG8_STAGE(PG8_SA(1, 0), a3, voffA);
            PG8_BAR; PG8_WAIT_L(0); PG8_MMA(1, 0, At, B0); PG8_BAR; PG8_SCHED;
            PG8_STAGE(PG8_SB(1, 1), b3 + hstep, voffB);
            PG8_WAIT_V(6); PG8_BAR; PG8_MMA(1, 1, At, B1); PG8_BAR;
            }
        }
        if constexpr (ALIGN_EPI) { if (wr == 0) PG8_BAR; }
        if constexpr (!Epi::AFTER_DRAIN) { E(acc, cur, wr, wc, fr, fq); S.done(cur); }
        if (!has_next) break;
#pragma unroll
        for (int a = 0; a < 2; ++a)
#pragma unroll
            for (int b = 0; b < 2; ++b)
#pragma unroll
                for (int m = 0; m < 4; ++m)
#pragma unroll
                    for (int n = 0; n < 2; ++n) acc[a][b][m][n] = (f32x4){0.f, 0.f, 0.f, 0.f};
        cur = nxt; cA = nA; cB = nB; ++ui;
        if constexpr (ALIGN_EPI) { if (wr == 1) PG8_BAR; }
    }
    PG8_WAIT_V(0);
    if constexpr (!ALIGN_EPI) { if (wr == 0) PG8_BAR; }
    PG8_BAR;
    if constexpr (Epi::AFTER_DRAIN) { E.fused(acc, cur, wr, wc, fr, fq, lds, wid, lane); S.done(cur); }
#undef PG8_SA
#undef PG8_SB
#undef PG8_STAGE
#undef PG8_LDA
#undef PG8_LDB
#undef PG8_MMA
#undef PG8_WAIT_V
#undef PG8_WAIT_L
#undef PG8_BAR
#undef PG8_SCHED
}
}
namespace attn_body {
using bf16=__hip_bfloat16;
using bf16x8=__attribute__((ext_vector_type(8)))short;
using s16x4=__attribute__((ext_vector_type(4)))short;
using f32x16=__attribute__((ext_vector_type(16)))float;
using u32x4=__attribute__((ext_vector_type(4)))unsigned;
constexpr int D=64;
constexpr int NW=8,QBLK=32,QB=QBLK*NW,KVBLK=64;
constexpr int ATTN_UNIT_ROWS=QB;
__device__ __forceinline__ int crow(int r,int hi){return (r&3)+8*(r>>2)+4*hi;}
#define SBAR() __builtin_amdgcn_sched_barrier(0)
typedef const __attribute__((address_space(3))) float* lds_cfptr;
__device__ __forceinline__ void nmask(f32x16&p0,f32x16&p1,int kr,int qr,int qc,int hi,lds_cfptr tab){
  const float NEG=-1e30f; int rs=qr-4; rs=rs<0?0:rs; rs=rs>56?56:rs; const int dr=kr-rs;
  if(dr<0||dr>=8){
    #pragma unroll
    for(int r=0;r<16;++r){p0[r]=NEG;p1[r]=NEG;}
    return; }
  int cs=qc-8; cs=cs<0?0:cs; cs=cs>48?48:cs;
  lds_cfptr trow=tab+((kr-qr+7)*31+15-qc);
  #pragma unroll
  for(int r=0;r<16;++r){ const int kc=(r&3)+8*(r>>2)+4*hi;
    const float b0=trow[kc], b1=trow[kc+32];
    p0[r]=((unsigned)(kc-cs)<16u)?p0[r]+b0:NEG; p1[r]=((unsigned)(kc+32-cs)<16u)?p1[r]+b1:NEG; }
}

constexpr int NSLOT=3, SLOTB=8192;
constexpr int LDS_K=0, LDS_V=NSLOT*SLOTB, LDS_WS=2*NSLOT*SLOTB, LDS_OST=LDS_WS+NW*64*4, LDS_BYTES=LDS_OST+NW*4096;
constexpr float C2=0.125f*1.4426950408889634f;
__device__ __forceinline__ void glds16(const void*gsrc,unsigned lds_dst){unsigned keep;
  asm volatile("s_mov_b32 %0, m0\n\ts_mov_b32 m0, %2\n\ts_nop 0\n\tglobal_load_lds_dwordx4 %1, off\n\ts_mov_b32 m0, %0":"=&s"(keep):"v"(gsrc),"s"(lds_dst):"memory");}
__device__ __forceinline__ float max3f(float a,float b,float c){float r;asm("v_max3_f32 %0, %1, %2, %3":"=v"(r):"v"(a),"v"(b),"v"(c));return r;}
__device__ __forceinline__ float max2f(float a,float b){float r;asm("v_max_f32_e32 %0, %1, %2":"=v"(r):"v"(a),"v"(b));return r;}
__device__ __forceinline__ float fadd_s(float a,float b){float r;asm("v_add_f32_e32 %0, %1, %2":"=v"(r):"v"(a),"v"(b));return r;}
__device__ __forceinline__ float fsub_s(float a,float b){float r;asm("v_sub_f32_e32 %0, %1, %2":"=v"(r):"v"(a),"v"(b));return r;}
typedef float f32x2_t __attribute__((ext_vector_type(2))); typedef __bf16 bf16x2_t __attribute__((ext_vector_type(2)));
__device__ __forceinline__ unsigned cvtpk_s(float lo,float hi){f32x2_t v={lo,hi};bf16x2_t b=__builtin_convertvector(v,bf16x2_t);return __builtin_bit_cast(unsigned,b);}
#define WAIT_BAR(N) asm volatile("s_waitcnt vmcnt(" #N ") lgkmcnt(0)\n\ts_barrier":::"memory")

__device__ __forceinline__ void qkt(f32x16&p0,f32x16&p1,const char*Kslot,const bf16x8*qr,const f32x16&negm,int r32,int hi){
  const char*kb=Kslot+hi*1024+r32*16;
  #pragma unroll
  for(int d0=0;d0<4;++d0){
    const bf16x8 b0=*reinterpret_cast<const bf16x8*>(kb+d0*2048);
    const bf16x8 b1=*reinterpret_cast<const bf16x8*>(kb+d0*2048+512);
    if(d0==0){p0=__builtin_amdgcn_mfma_f32_32x32x16_bf16(b0,qr[0],negm,0,0,0);p1=__builtin_amdgcn_mfma_f32_32x32x16_bf16(b1,qr[0],negm,0,0,0);}
    else{p0=__builtin_amdgcn_mfma_f32_32x32x16_bf16(b0,qr[d0],p0,0,0,0);p1=__builtin_amdgcn_mfma_f32_32x32x16_bf16(b1,qr[d0],p1,0,0,0);}}
}
typedef __attribute__((address_space(3))) const char* lds_cptr;
typedef short v4i16_t __attribute__((ext_vector_type(4)));
__device__ __forceinline__ void kload8(bf16x8*kf,lds_cptr kp){
  kf[0]=*(const __attribute__((address_space(3))) bf16x8*)(kp);      kf[1]=*(const __attribute__((address_space(3))) bf16x8*)(kp+512);
  kf[2]=*(const __attribute__((address_space(3))) bf16x8*)(kp+2048); kf[3]=*(const __attribute__((address_space(3))) bf16x8*)(kp+2560);
  kf[4]=*(const __attribute__((address_space(3))) bf16x8*)(kp+4096); kf[5]=*(const __attribute__((address_space(3))) bf16x8*)(kp+4608);
  kf[6]=*(const __attribute__((address_space(3))) bf16x8*)(kp+6144); kf[7]=*(const __attribute__((address_space(3))) bf16x8*)(kp+6656);
}
__device__ __forceinline__ void kload2(bf16x8*kf,lds_cptr kp,int j){ kf[2*j]=*(const __attribute__((address_space(3))) bf16x8*)(kp+j*2048); kf[2*j+1]=*(const __attribute__((address_space(3))) bf16x8*)(kp+j*2048+512); }
__device__ __forceinline__ s16x4 vtr(lds_cptr p){ return __builtin_bit_cast(s16x4,__builtin_amdgcn_ds_read_tr16_b64_v4i16((__attribute__((address_space(3))) v4i16_t*)p)); }
__device__ __forceinline__ float rowmax(const f32x16&p0,const f32x16&p1){
  float a=max3f(p0[0],p0[1],p1[0]),b=max3f(p0[2],p0[3],p1[1]);a=max3f(a,p1[2],p1[3]);
  #pragma unroll
  for(int r=4;r<16;r+=4){a=max3f(a,p0[r],p0[r+1]);b=max3f(b,p0[r+2],p0[r+3]);a=max3f(a,p1[r],p1[r+1]);b=max3f(b,p1[r+2],p1[r+3]);}
  const float m=max2f(a,b);
  auto rr=__builtin_amdgcn_permlane32_swap(__float_as_uint(m),__float_as_uint(m),false,false);
  return max2f(__uint_as_float(rr[0]),__uint_as_float(rr[1]));
}
__device__ __forceinline__ void pv(f32x16*o,int vb,bf16x8 pa0,bf16x8 pa1,bf16x8 pa2,bf16x8 pa3){
  #pragma unroll
  for(int d0=0;d0<2;++d0){s16x4 lo[4],hi[4];
    #pragma unroll
    for(int ks=0;ks<4;++ks){
      asm volatile("ds_read_b64_tr_b16 %0,%1 offset:%c2":"=&v"(lo[ks]):"v"(vb),"i"(d0*4096+ks*1024):"memory");
      asm volatile("ds_read_b64_tr_b16 %0,%1 offset:%c2":"=&v"(hi[ks]):"v"(vb),"i"(d0*4096+ks*1024+512):"memory");}
    asm volatile("s_waitcnt lgkmcnt(0)":::"memory");SBAR();
    #define PK(k) (bf16x8){lo[k][0],lo[k][1],lo[k][2],lo[k][3],hi[k][0],hi[k][1],hi[k][2],hi[k][3]}
    o[d0]=__builtin_amdgcn_mfma_f32_32x32x16_bf16(pa0,PK(0),o[d0],0,0,0);
    o[d0]=__builtin_amdgcn_mfma_f32_32x32x16_bf16(pa1,PK(1),o[d0],0,0,0);
    o[d0]=__builtin_amdgcn_mfma_f32_32x32x16_bf16(pa2,PK(2),o[d0],0,0,0);
    o[d0]=__builtin_amdgcn_mfma_f32_32x32x16_bf16(pa3,PK(3),o[d0],0,0,0);
    #undef PK
  }
}

#ifndef ATTN_STORE16
#define ATTN_STORE16(p,v) (*(u32x4*)(p)=(v))
#endif
struct AttnUnitArgs { const bf16* Q; long qp; const bf16* K0; const bf16* V0; const bf16* K1; const bf16* V1; long kp; int tsplit, tmax, NT; bf16* O; long op; int r0, krow0; const float* rpb; };
template<int MODE,int THRL> __device__ __forceinline__ void attn_unit(const AttnUnitArgs&A,char*shm){
  const int tid=tid_now(),lane=tid&63,r32=lane&31,hi=lane>>5; const int wid=__builtin_amdgcn_readfirstlane(tid>>6);
  const long DMk=A.kp;
  const bf16*Qw=A.Q+(long)(wid*QBLK)*A.qp;
  const unsigned lds0=(unsigned)(uintptr_t)shm;
  float*wsf=(float*)(shm+LDS_WS)+wid*64;
  const long klane=(long)lane*DMk+wid*8;
  const long vlane=(long)(16*(wid&3)+(lane>>2))*DMk+(wid>>2)*32+(lane&3)*8;
  const int tsplit=A.tsplit,tmax=A.tmax;
  #define TOFF(t) ((long)(((t)-tsplit)>tmax?tmax:((t)-tsplit))*KVBLK*DMk)
  const unsigned kdst=lds0+LDS_K+wid*1024, vdst=lds0+LDS_V+wid*1024;
  #define DMA_K(t,slot) glds16(((t)<tsplit?A.K0+(long)(t)*KVBLK*DMk:A.K1+TOFF(t))+klane,(unsigned)__builtin_amdgcn_readfirstlane(kdst+(slot)))
  #define DMA_V(t,slot) glds16(((t)<tsplit?A.V0+(long)(t)*KVBLK*DMk:A.V1+TOFF(t))+vlane,(unsigned)__builtin_amdgcn_readfirstlane(vdst+(slot)))
  const int vb0=(int)(lds0+LDS_V)+((lane>>4)&1)*32+(lane&3)*8+(4*hi+((lane&15)>>2))*64;
  const char*Kbase=shm+LDS_K; bf16x8 kf[8];
  const lds_cptr shm3=(lds_cptr)shm; const lds_cptr kp0=shm3+LDS_K+hi*1024+r32*16; const lds_cptr vp0=shm3+LDS_V+((lane>>4)&1)*32+(lane&3)*8+(4*hi+((lane&15)>>2))*64;
  const int NT=A.NT;
  const lds_cfptr tab=(lds_cfptr)(shm3+LDS_BYTES);
  if(MODE==1){ __attribute__((address_space(3))) float* tw=(__attribute__((address_space(3))) float*)(shm3+LDS_BYTES); for(int i=tid;i<465;i+=512)tw[i]=A.rpb[i]*1.4426950408889634f; }
  const int nqr=A.r0+(wid>>1), nqc=(wid&1)*32+r32;
  DMA_K(0,0);DMA_V(0,0);DMA_K(1,SLOTB);
  bf16x8 qr[4];
  #pragma unroll
  for(int d0=0;d0<4;++d0)qr[d0]=*reinterpret_cast<const bf16x8*>(&Qw[(long)r32*A.qp+d0*16+hi*8]);
  float mhat=0.f,l_reg=0.f;f32x16 o[2];o[0]=f32x16{};o[1]=f32x16{};f32x16 negm=f32x16{};asm volatile("":"+v"(negm));
  #define CMASK(P0,P1,t) do{ if(MODE==1){ const int kt_=(t)-tsplit; if(kt_>=0)nmask(P0,P1,A.krow0+kt_,nqr,nqc,hi,tab); } }while(0)
  bool resc=false;
  #define START(P0,P1) do{ const float rm=rowmax(P0,P1); resc=false; \
    { const float dl=rm; mhat=fadd_s(mhat,dl); \
      _Pragma("unroll") for(int r=0;r<16;++r){P0[r]=fsub_s(P0[r],dl);P1[r]=fsub_s(P1[r],dl);} \
      _Pragma("unroll") for(int r=0;r<16;++r)negm[r]=-mhat; asm volatile("":"+v"(negm)); } \
    _Pragma("unroll") for(int r=0;r<16;++r)P0[r]=__builtin_amdgcn_exp2f(P0[r]); }while(0)
  #define RESC() do{ if(resc){ asm volatile("s_waitcnt lgkmcnt(0)":::"memory"); \
      _Pragma("unroll") for(int d_=0;d_<2;++d_) _Pragma("unroll") for(int r=0;r<16;++r)o[d_][r]*=wsf[crow(r,hi)]; } }while(0)
  f32x16 pA0,pA1,pB0,pB1;
  int sl_prev=0,sl_cur=0,sl_next=SLOTB;
  #define ROT() do{sl_prev=sl_cur;sl_cur=sl_next;sl_next=(sl_next==(NSLOT-1)*SLOTB)?0:sl_next+SLOTB;}while(0)
  DMA_K(2,2*SLOTB);
  WAIT_BAR(3);
  qkt(pA0,pA1,Kbase,qr,negm,r32,hi);asm volatile("s_nop 15\n\ts_nop 7":"+v"(pA0),"+v"(pA1));CMASK(pA0,pA1,0);
  START(pA0,pA1);
  _Pragma("unroll") for(int r=0;r<16;++r)pA1[r]=__builtin_amdgcn_exp2f(pA1[r]);
  WAIT_BAR(0);
  DMA_K(3,0);DMA_V(1,SLOTB);
  ROT();
  kload8(kf,kp0+sl_cur);
  WAIT_BAR(2);
  s16x4 vlo[8],vhi[8]; u32x4 pw0,pw1,pw2,pw3;
  #define PKW(P,B) cvtpk_s(P[B],P[B+1])
  #define PAF(k) __builtin_bit_cast(bf16x8,pw##k)
  #define VFR(i) (bf16x8){vlo[i][0],vlo[i][1],vlo[i][2],vlo[i][3],vhi[i][0],vhi[i][1],vhi[i][2],vhi[i][3]}
  #define PIN(x) asm volatile("":"+v"(x))
  #define MX3(a,b,c) __builtin_fmaxf(__builtin_fmaxf((a),(b)),(c))
  #define GAPA(MF,A0,A1,A2,A3,W0,W1,PW) do{ MF; sacc+=A0; sacc+=A1; sacc+=A2; sacc+=A3; PIN(sacc); W0; W1; PIN(PW); SBAR(); }while(0)
  #define EX(v) __builtin_amdgcn_exp2f(v)
  #define GAPB(MF,X,B) do{ MF; X[B]=EX(X[B]); X[B+1]=EX(X[B+1]); X[B+2]=EX(X[B+2]); X[B+3]=EX(X[B+3]); PIN(X); SBAR(); }while(0)
  #define VRD(i) do{ vlo[i]=vtr(vp_+(((i)>>2)*4096+((i)&3)*1024)); vhi[i]=vtr(vp_+(((i)>>2)*4096+((i)&3)*1024+512)); }while(0)
  #define KRD(G,j) do{ if(G){ kload2(kf,kp0+sl_next,j); SBAR(); } }while(0)
  #define STEP(C0,C1,P0,P1,t,GK,GV,GL) do{ SBAR(); \
    const lds_cptr vp_=vp0+sl_prev; \
    VRD(0); SBAR(); float sacc=(P0[0]+P0[1]); \
    GAPA(C0=__builtin_amdgcn_mfma_f32_32x32x16_bf16(kf[0],qr[0],negm,0,0,0), P0[2],P0[3],P0[4],P0[5],     pw0[0]=PKW(P0,0), pw0[1]=PKW(P0,2), pw0); \
    VRD(4); SBAR(); GAPA(C1=__builtin_amdgcn_mfma_f32_32x32x16_bf16(kf[1],qr[0],negm,0,0,0), P0[6],P0[7],P0[8],P0[9],     pw0[2]=PKW(P0,4), pw0[3]=PKW(P0,6), pw0); \
    VRD(1); SBAR(); GAPA(C0=__builtin_amdgcn_mfma_f32_32x32x16_bf16(kf[2],qr[1],C0,0,0,0),   P0[10],P0[11],P0[12],P0[13], pw1[0]=PKW(P0,8), pw1[1]=PKW(P0,10), pw1); \
    VRD(5); SBAR(); GAPA(C1=__builtin_amdgcn_mfma_f32_32x32x16_bf16(kf[3],qr[1],C1,0,0,0),   P0[14],P0[15],P1[0],P1[1],   pw1[2]=PKW(P0,12),pw1[3]=PKW(P0,14), pw1); \
    VRD(2); SBAR(); GAPA(C0=__builtin_amdgcn_mfma_f32_32x32x16_bf16(kf[4],qr[2],C0,0,0,0),   P1[2],P1[3],P1[4],P1[5],     pw2[0]=PKW(P1,0), pw2[1]=PKW(P1,2), pw2); \
    VRD(6); SBAR(); GAPA(C1=__builtin_amdgcn_mfma_f32_32x32x16_bf16(kf[5],qr[2],C1,0,0,0),   P1[6],P1[7],P1[8],P1[9],     pw2[2]=PKW(P1,4), pw2[3]=PKW(P1,6), pw2); \
    VRD(3); SBAR(); GAPA(C0=__builtin_amdgcn_mfma_f32_32x32x16_bf16(kf[6],qr[3],C0,0,0,0),   P1[10],P1[11],P1[12],P1[13], pw3[0]=PKW(P1,8), pw3[1]=PKW(P1,10), pw3); \
    VRD(7); SBAR(); GAPA(C1=__builtin_amdgcn_mfma_f32_32x32x16_bf16(kf[7],qr[3],C1,0,0,0),   P1[14],P1[15],0.f,0.f,       pw3[2]=PKW(P1,12),pw3[3]=PKW(P1,14), pw3); \
    l_reg+=sacc; \
    if(GK){DMA_K((t)+3,sl_cur);} if(GV){DMA_V((t)+1,sl_next);} \
    CMASK(C0,C1,t); \
    { float a=MX3(C0[0],C0[1],C1[0]),b=MX3(C0[2],C0[3],C1[1]); a=MX3(a,C1[2],C1[3]); \
      _Pragma("unroll") for(int r=4;r<16;r+=4){a=MX3(a,C0[r],C0[r+1]);b=MX3(b,C0[r+2],C0[r+3]);a=MX3(a,C1[r],C1[r+1]);b=MX3(b,C1[r+2],C1[r+3]);} \
      float rm=__builtin_fmaxf(a,b); { auto rr=__builtin_amdgcn_permlane32_swap(__float_as_uint(rm),__float_as_uint(rm),false,false); rm=__builtin_fmaxf(__uint_as_float(rr[0]),__uint_as_float(rr[1])); } \
      resc=false; \
      if(__builtin_expect(__any(rm>(float)THRL),0)){ const float dl=__builtin_fmaxf(rm,0.f); mhat+=dl; \
        _Pragma("unroll") for(int r=0;r<16;++r){C0[r]-=dl;C1[r]-=dl;} \
        _Pragma("unroll") for(int r=0;r<16;++r)negm[r]=-mhat; asm volatile("":"+v"(negm)); \
        const float f=__builtin_amdgcn_exp2f(-dl); l_reg*=f; if(hi==0)wsf[r32]=f; resc=true; } } \
    SBAR(); \
    GAPB(o[0]=__builtin_amdgcn_mfma_f32_32x32x16_bf16(PAF(0),VFR(0),o[0],0,0,0), C0,0); \
    GAPB(o[1]=__builtin_amdgcn_mfma_f32_32x32x16_bf16(PAF(0),VFR(4),o[1],0,0,0), C0,4); \
    KRD(GL,0); GAPB(o[0]=__builtin_amdgcn_mfma_f32_32x32x16_bf16(PAF(1),VFR(1),o[0],0,0,0), C0,8); \
    KRD(GL,1); GAPB(o[1]=__builtin_amdgcn_mfma_f32_32x32x16_bf16(PAF(1),VFR(5),o[1],0,0,0), C0,12); \
    KRD(GL,2); GAPB(o[0]=__builtin_amdgcn_mfma_f32_32x32x16_bf16(PAF(2),VFR(2),o[0],0,0,0), C1,0); \
    KRD(GL,3); GAPB(o[1]=__builtin_amdgcn_mfma_f32_32x32x16_bf16(PAF(2),VFR(6),o[1],0,0,0), C1,4); \
    GAPB(o[0]=__builtin_amdgcn_mfma_f32_32x32x16_bf16(PAF(3),VFR(3),o[0],0,0,0), C1,8); \
    GAPB(o[1]=__builtin_amdgcn_mfma_f32_32x32x16_bf16(PAF(3),VFR(7),o[1],0,0,0), C1,12); \
    }while(0)
  int t=1;
  for(;t+5<NT;t+=2){
    STEP(pB0,pB1,pA0,pA1,t,true,true,true);     WAIT_BAR(2); RESC(); ROT();
    STEP(pA0,pA1,pB0,pB1,t+1,true,true,true);   WAIT_BAR(2); RESC(); ROT();
  }
  #undef CMASK
  #define CMASK(P0,P1,t) do{ if(MODE==1){ const int kt_=(t)-tsplit; if(kt_>=0)nmask(P0,P1,A.krow0+kt_,nqr,nqc,hi,tab); } }while(0)
  #define ENDW(tt) do{ if((tt)+3<NT){WAIT_BAR(2);} else if((tt)+2<NT){WAIT_BAR(1);} else {WAIT_BAR(0);} }while(0)
  for(;t+1<NT;t+=2){
    STEP(pB0,pB1,pA0,pA1,t,(t+3<NT),(t+1<NT),(t+1<NT));       ENDW(t);   RESC(); ROT();
    STEP(pA0,pA1,pB0,pB1,t+1,(t+4<NT),(t+2<NT),(t+2<NT));     ENDW(t+1); RESC(); ROT();
  }
  STEP(pB0,pB1,pA0,pA1,NT-1,false,false,false); RESC();
  { float sacc=pB0[0]+pB0[1]; _Pragma("unroll") for(int r=2;r<16;++r)sacc+=pB0[r]; _Pragma("unroll") for(int r=0;r<16;++r)sacc+=pB1[r]; l_reg+=sacc;
    pw0=(u32x4){PKW(pB0,0),PKW(pB0,2),PKW(pB0,4),PKW(pB0,6)};pw1=(u32x4){PKW(pB0,8),PKW(pB0,10),PKW(pB0,12),PKW(pB0,14)};pw2=(u32x4){PKW(pB1,0),PKW(pB1,2),PKW(pB1,4),PKW(pB1,6)};pw3=(u32x4){PKW(pB1,8),PKW(pB1,10),PKW(pB1,12),PKW(pB1,14)};
    SBAR(); pv(o,vb0+sl_cur,PAF(0),PAF(1),PAF(2),PAF(3)); }
  #undef PKW
  #undef PAF
  #undef VFR
  #undef PIN
  #undef MX3
  #undef GAPA
  #undef GAPB
  #undef EX
  #undef VRD
  #undef KRD
  #undef STEP
  #undef ENDW
  {auto rr=__builtin_amdgcn_permlane32_swap(__float_as_uint(l_reg),__float_as_uint(l_reg),false,false);l_reg=__uint_as_float(rr[0])+__uint_as_float(rr[1]);}
  if(hi==0)wsf[32+r32]=l_reg;asm volatile("s_waitcnt lgkmcnt(0)":::"memory");
  float rli[16];
  #pragma unroll
  for(int r=0;r<16;++r)rli[r]=__builtin_amdgcn_rcpf(wsf[32+crow(r,hi)]);
  bf16*Ow=A.O+(long)(wid*QBLK)*A.op;
  { bf16*stg=(bf16*)(shm+LDS_OST)+wid*2048;
    #pragma unroll
    for(int r=0;r<16;++r){const int orow=crow(r,hi);
      #pragma unroll
      for(int d0=0;d0<2;++d0)stg[orow*64+d0*32+r32]=__float2bfloat16(o[d0][r]*rli[r]);}
    asm volatile("s_waitcnt lgkmcnt(0)":::"memory");
    #pragma unroll
    for(int i=0;i<4;++i){const int row=i*8+(lane>>3),ch=lane&7; const u32x4 v=*(const u32x4*)(stg+row*64+ch*8); ATTN_STORE16(Ow+(long)row*A.op+ch*8,v);} }
  asm volatile("s_waitcnt lgkmcnt(0)\n\ts_barrier":::"memory");
  #undef DMA_K
  #undef TOFF
  #undef DMA_V
  #undef CMASK
  #undef START
  #undef RESC
  #undef ROT
}
constexpr int ATTN_LDS_BYTES=LDS_BYTES+2048;
#undef SBAR
#undef WAIT_BAR
}
static_assert(attn_body::ATTN_LDS_BYTES <= RING_BYTES, "attention scratch fits the ring");

#define GAS __attribute__((address_space(1)))
#define LAS __attribute__((address_space(3)))
typedef unsigned short bf16;
typedef unsigned v4u __attribute__((ext_vector_type(4)));
typedef unsigned v2u __attribute__((ext_vector_type(2)));
typedef float f32x4 __attribute__((ext_vector_type(4)));
#define LDS_WAIT() asm volatile("s_waitcnt lgkmcnt(0)" ::: "memory")
__device__ __forceinline__ unsigned f2bf(float f) { unsigned u = __builtin_bit_cast(unsigned, f); return (u + 0x7fffu + ((u >> 16) & 1u)) >> 16; }
__device__ __forceinline__ unsigned pk2(float lo, float hi) { return f2bf(lo) | (f2bf(hi) << 16); }
__device__ __forceinline__ float bf_lo(unsigned w) { return __builtin_bit_cast(float, w << 16); }
__device__ __forceinline__ float bf_hi(unsigned w) { return __builtin_bit_cast(float, w & 0xffff0000u); }
__device__ __forceinline__ float wave_sum(float v) {
#pragma unroll
    for (int o = 1; o < 64; o <<= 1) v += __shfl_xor(v, o);
    return v;
}

typedef GAS unsigned gu32;
#define RLX_AGENT __ATOMIC_RELAXED, __HIP_MEMORY_SCOPE_AGENT
#define XB_TMO      128
#define XB_XCNT(j)  (256  + 64 * (j))
#define XB_XSUB(j)  (1280 + 64 * (j))
#define XB_XGEN(j)  (2304 + 64 * (j))
#define XB_TOP      3328
#define XB_TOPGEN   3392
#define XCD_BAR_WORDS 3456
#define XB_SPIN_CAP (1u << 18)

__device__ __forceinline__ unsigned xb_ld(unsigned* p)              { return __hip_atomic_load(p, __ATOMIC_RELAXED, __HIP_MEMORY_SCOPE_AGENT); }
__device__ __forceinline__ unsigned xb_add(unsigned* p, unsigned v) { return __hip_atomic_fetch_add(p, v, __ATOMIC_RELAXED, __HIP_MEMORY_SCOPE_AGENT); }
__device__ __forceinline__ unsigned xb_xcc_id() { return (unsigned)__builtin_amdgcn_s_getreg((3 << 11) | 20) & 0xFu; }
#define XB_SPIN(cond, bar) do { unsigned _sp = 0; while (cond) { __builtin_amdgcn_s_sleep(1); \
    if ((++_sp & 255u) == 0u) { if (xb_ld(&(bar)[XB_TMO])) break; if (_sp > XB_SPIN_CAP) { atomicAdd(&(bar)[XB_TMO], 1u); break; } } } } while (0)

struct XcdBarrier {
    unsigned* bar; unsigned x;
    volatile LAS unsigned* st;
};

__device__ __forceinline__ XcdBarrier xcd_barrier_post(unsigned* bar, volatile LAS unsigned* st) {
    XcdBarrier b; b.bar = bar; b.x = xb_xcc_id(); b.st = st;
    if (threadIdx.x == 0) (void)xb_add(&bar[XB_XCNT(b.x)], 1u);
    return b;
}
__device__ __forceinline__ void xcd_barrier_complete(unsigned* bar, unsigned x, unsigned& nloc, unsigned& nx) {
    const unsigned G = gridDim.x * gridDim.y * gridDim.z;
    unsigned sum, cnt, mine, sp = 0u;
    for (;;) {
        sum = 0u; cnt = 0u; mine = 0u;
#pragma unroll
        for (unsigned j = 0; j < 16; ++j) { const unsigned c = xb_ld(&bar[XB_XCNT(j)]); sum += c; cnt += (c > 0u) ? 1u : 0u; mine = (j == x) ? c : mine; }
        if (sum == G) break;
        __builtin_amdgcn_s_sleep(1);
        if ((++sp & 255u) == 0u) { if (xb_ld(&bar[XB_TMO])) break; if (sp > XB_SPIN_CAP) { atomicAdd(&bar[XB_TMO], 1u); break; } }
    }
    nloc = mine > 0u ? mine : 1u; nx = cnt > 0u ? cnt : 1u;
}

__device__ __forceinline__ void xcd_barrier(const XcdBarrier& b) {
    asm volatile("s_waitcnt vmcnt(0)" ::: "memory");
    __syncthreads();
    if (threadIdx.x == 0) {
        unsigned* bar = b.bar;
        __builtin_amdgcn_s_waitcnt(0);
        unsigned nloc = b.st[0], nx = b.st[1];
        if (nloc == 0u) { xcd_barrier_complete(bar, b.x, nloc, nx); b.st[0] = nloc; b.st[1] = nx; }
        const unsigned old = xb_add(&bar[XB_XSUB(b.x)], 1u);
        const unsigned gen = old / nloc;
        if (old + 1u == (gen + 1u) * nloc) {
            __builtin_amdgcn_fence(__ATOMIC_RELEASE, "agent");
            asm volatile("s_waitcnt vmcnt(0)" ::: "memory");
            const unsigned og = xb_add(&bar[XB_TOP], 1u);
            const unsigned tg = og / nx;
            if (og + 1u == (tg + 1u) * nx) xb_add(&bar[XB_TOPGEN], 1u);
            else XB_SPIN(xb_ld(&bar[XB_TOPGEN]) == tg, bar);
            __builtin_amdgcn_fence(__ATOMIC_ACQUIRE, "agent");
            xb_add(&bar[XB_XGEN(b.x)], 1u);
            asm volatile("s_waitcnt vmcnt(0)" ::: "memory");
        } else {
            XB_SPIN(xb_ld(&bar[XB_XGEN(b.x)]) == gen, bar);
            __builtin_amdgcn_fence(__ATOMIC_ACQUIRE, "agent");
            asm volatile("s_waitcnt vmcnt(0)" ::: "memory");
        }
    }
    __syncthreads();
}

struct Args { const float* in[23]; float* out; unsigned char* ws; };
typedef const __attribute__((address_space(4))) Args* KArgs;
enum { I_XP = 0, I_XS, I_CNBK, I_CNBV, I_CATK, I_CATV, I_C, I_CCTX, I_WMOD, I_BMOD, I_GNORM, I_WFI, I_WFO, I_WIAB, I_WPOOL, I_PSCALE, I_RPB, I_WOAB, I_WQKV, I_GQ, I_GK, I_WOC, I_GFINAL };

__device__ __forceinline__ void tr_item(const float* W, int ldw, int k0, int n0, bf16* WT, int ldt, int nrow0, int kdst0, LAS float* scr, int lane) {
    float tv[32];
#pragma unroll
    for (int i = 0; i < 32; ++i) { const int kk = 2 * i + (lane >> 5); tv[i] = W[(size_t)(k0 + kk) * ldw + n0 + (lane & 31)]; }
#pragma unroll
    for (int i = 0; i < 32; ++i) { const int kk = 2 * i + (lane >> 5); scr[kk * 33 + (lane & 31)] = tv[i]; }
    LDS_WAIT(); asm volatile("" ::: "memory");
    const int c = lane & 7;
#pragma unroll
    for (int j = 0; j < 4; ++j) { const int n = (lane >> 3) + 8 * j; const LAS float* s = scr + (8 * c) * 33 + n;
        v4u o; o.x = pk2(s[0 * 33], s[1 * 33]); o.y = pk2(s[2 * 33], s[3 * 33]); o.z = pk2(s[4 * 33], s[5 * 33]); o.w = pk2(s[6 * 33], s[7 * 33]);
        *(v4u*)(WT + (size_t)(nrow0 + n) * ldt + kdst0 + 8 * c) = o; }
    LDS_WAIT(); asm volatile("" ::: "memory");
}

__device__ __forceinline__ void prologue_a(KArgs a, LAS unsigned char* lds, int vcu, int G, int wave, int lane) {
    unsigned char* ws = a->ws;
    LAS float* scr = (LAS float*)(lds + RING_OFF + wave * 16384);
    const int gw = vcu * NWAVES + wave, NGW = G * NWAVES;
    constexpr int N_ADA = 4 * 36 * ADA_KC;
    constexpr int I_FI = 16 * 176, I_FO = 44 * 32, I_IAB = 16 * 64, I_OAB = 8 * 32, I_QKV = 16 * 48, I_OC = 16 * 32;
    constexpr int N_TR = 8 * I_FI + 8 * I_FO + 2 * I_IAB + 2 * I_OAB + 2 * I_QKV + 2 * I_OC;
    constexpr int N_PW = 2 * 1024, N_CNB = 2 * 1024, N_CAT = 2 * 1024, N_ROPE = 16;
    constexpr int NTASK = N_ADA + N_PW + N_TR + N_CNB + N_CAT + N_ROPE;
    for (int it = gw; it < NTASK; it += NGW) {
        int r = it;
        if (r < N_ADA) {
            const int kc = r % ADA_KC, cb = (r / ADA_KC) % 36, l = r / (ADA_KC * 36);
            const float* W = a->in[I_WMOD] + ((size_t)l * 1024 + kc * 64) * 9216 + cb * 256 + lane * 4;
            float sv[5];
            { const int k = kc * 64 + lane; const float c0 = a->in[I_CCTX][k]; sv[0] = pg8::silu_f(c0);
#pragma unroll
              for (int ms = 1; ms < 5; ++ms) sv[ms] = pg8::silu_f(a->in[I_C][(ms - 1) * 1024 + k]); }
            f32x4 acc[5];
#pragma unroll
            for (int ms = 0; ms < 5; ++ms) acc[ms] = (f32x4){0.f, 0.f, 0.f, 0.f};
#pragma unroll 16
            for (int kk = 0; kk < 64; ++kk) { const f32x4 w = *(const f32x4*)(W + (size_t)kk * 9216);
#pragma unroll
                for (int ms = 0; ms < 5; ++ms) { const float s = __builtin_bit_cast(float, __builtin_amdgcn_readlane(__builtin_bit_cast(int, sv[ms]), kk)); acc[ms] += w * s; } }
            float* P = (float*)(ws + WS_MODP);
#pragma unroll
            for (int ms = 0; ms < 5; ++ms) *(f32x4*)(P + ((size_t)(kc * 4 + l) * 5 + ms) * 9216 + cb * 256 + lane * 4) = acc[ms];
            continue;
        }
        r -= N_ADA;
        if (r < N_PW) {
            const int e = r >> 10, rr = r & 1023, k0 = (rr >> 4) * 8, n = (rr & 15) * 64 + lane, g = k0 >> 7, c0 = k0 & 127;
            const float* wo = a->in[I_WOAB] + (size_t)e * 1024 * 1024 + (size_t)(g * 128) * 1024 + n;
            const float* ps = a->in[I_PSCALE] + e * 512 + g * 128;
            const float* wp = a->in[I_WPOOL] + ((size_t)(e * 4 + g) * 128 + c0) * 128;
            float acc[8];
#pragma unroll
            for (int j = 0; j < 8; ++j) acc[j] = 0.f;
#pragma unroll 16
            for (int d = 0; d < 128; ++d) { const float w = wo[(size_t)d * 1024] * ps[d];
#pragma unroll
                for (int j = 0; j < 8; ++j) acc[j] += wp[j * 128 + d] * w; }
            v4u o; o.x = pk2(acc[0], acc[1]); o.y = pk2(acc[2], acc[3]); o.z = pk2(acc[4], acc[5]); o.w = pk2(acc[6], acc[7]);
            *(v4u*)((bf16*)(ws + WS_WOAB) + (size_t)e * 1024 * 1024 + (size_t)n * 1024 + k0) = o;
            continue;
        }
        r -= N_PW;
        if (r < N_TR) {
            if (r < 8 * I_FI) { const int mat = r / I_FI, it2 = r % I_FI, kb = it2 / 176, nb = it2 % 176; const int n0 = 32 * nb; const int bj = n0 >= DFF ? 1 : 0, j = n0 - bj * DFF;
                tr_item(a->in[I_WFI] + (size_t)mat * 1024 * NFF, NFF, 64 * kb, n0, (bf16*)(ws + WS_WFI) + (size_t)mat * NFF * 1024, 1024, 256 * (j >> 7) + 128 * bj + (j & 127), 64 * kb, scr, lane); continue; }
            r -= 8 * I_FI;
            if (r < 8 * I_FO) { const int mat = r / I_FO, it2 = r % I_FO, kb = it2 / 32, nb = it2 % 32; const int k0 = 64 * kb; constexpr int KC = DFF / FFO_KS; const int ks = k0 / KC;
                tr_item(a->in[I_WFO] + (size_t)mat * DFF * 1024, 1024, k0, 32 * nb, (bf16*)(ws + WS_WFO) + (size_t)mat * DFF * 1024 + (size_t)ks * 1024 * KC, KC, 32 * nb, k0 - ks * KC, scr, lane); continue; }
            r -= 8 * I_FO;
            if (r < 2 * I_IAB) { const int e = r / I_IAB, it2 = r % I_IAB, kb = it2 / 64, nb = it2 % 64;
                tr_item(a->in[I_WIAB] + (size_t)e * 1024 * 2048, 2048, 64 * kb, 32 * nb, (bf16*)(ws + WS_WIAB) + (size_t)e * 2048 * 1024, 1024, 32 * nb, 64 * kb, scr, lane); continue; }
            r -= 2 * I_IAB;
            if (r < 2 * I_OAB) { const int e = r / I_OAB, it2 = r % I_OAB, kb = it2 / 32, nb = it2 % 32; constexpr int KC = 1024 / OUT_KS; const int kd = 512 + 64 * kb, ks = kd / KC;
                tr_item(a->in[I_WOAB] + (size_t)e * 1024 * 1024 + (size_t)512 * 1024, 1024, 64 * kb, 32 * nb, (bf16*)(ws + WS_WOAB) + (size_t)e * 1024 * 1024 + (size_t)ks * 1024 * KC, KC, 32 * nb, kd - ks * KC, scr, lane); continue; }
            r -= 2 * I_OAB;
            if (r < 2 * I_QKV) { const int o = r / I_QKV, it2 = r % I_QKV, kb = it2 / 48, nb = it2 % 48;
                tr_item(a->in[I_WQKV] + (size_t)o * 1024 * 1536, 1536, 64 * kb, 32 * nb, (bf16*)(ws + WS_WQKV) + (size_t)o * 1536 * 1024, 1024, 32 * nb, 64 * kb, scr, lane); continue; }
            r -= 2 * I_QKV;
            { const int o = r / I_OC, it2 = r % I_OC, kb = it2 / 32, nb = it2 % 32; constexpr int KC = 1024 / OUT_KS; const int k0 = 64 * kb, ks = k0 / KC;
                tr_item(a->in[I_WOC] + (size_t)o * 1024 * 1024, 1024, k0, 32 * nb, (bf16*)(ws + WS_WOC) + (size_t)o * 1024 * 1024 + (size_t)ks * 1024 * KC, KC, 32 * nb, k0 - ks * KC, scr, lane); continue; }
        }
        r -= N_TR;
        if (r < N_CNB) {
            const int e = r >> 10, rr = r & 1023, b = rr >> 8, s = rr & 255;
            const size_t so = ((size_t)(b * 2 + e) * 256 + s) * 512 + lane * 8;
            bf16* dst = (bf16*)(ws + WS_CTXNB) + (size_t)e * 1024 * 2048 + (size_t)rr * 2048 + lane * 8;
            { const f32x4 x0 = *(const f32x4*)(a->in[I_CNBK] + so), x1 = *(const f32x4*)(a->in[I_CNBK] + so + 4); v4u o; o.x = pk2(x0[0], x0[1]); o.y = pk2(x0[2], x0[3]); o.z = pk2(x1[0], x1[1]); o.w = pk2(x1[2], x1[3]); *(v4u*)(dst + 1024) = o; }
            { const f32x4 x0 = *(const f32x4*)(a->in[I_CNBV] + so), x1 = *(const f32x4*)(a->in[I_CNBV] + so + 4); v4u o; o.x = pk2(x0[0], x0[1]); o.y = pk2(x0[2], x0[3]); o.z = pk2(x1[0], x1[1]); o.w = pk2(x1[2], x1[3]); *(v4u*)(dst + 1536) = o; }
            continue;
        }
        r -= N_CNB;
        if (r < N_CAT) {
            const int o = r >> 10, rr = r & 1023, b = rr >> 8, s = rr & 255;
            const size_t so = ((size_t)(b * 2 + o) * 256 + s) * 256 + lane * 4; const size_t dofs = (size_t)o * KCAT_STRIDE + ((size_t)b * 4352 + s) * 256 + lane * 4;
            { const f32x4 x0 = *(const f32x4*)(a->in[I_CATK] + so); v2u w; w.x = pk2(x0[0], x0[1]); w.y = pk2(x0[2], x0[3]); *(v2u*)((bf16*)(ws + WS_KCAT) + dofs) = w; }
            { const f32x4 x0 = *(const f32x4*)(a->in[I_CATV] + so); v2u w; w.x = pk2(x0[0], x0[1]); w.y = pk2(x0[2], x0[3]); *(v2u*)((bf16*)(ws + WS_VCAT) + dofs) = w; }
            continue;
        }
        r -= N_CAT;
        {
            const int idx = r * 64 + lane, pos = idx >> 4, i = idx & 15;
            const float inv = __builtin_amdgcn_exp2f(-(float)i * (13.287712379549449f / 16.0f)), ang = (float)pos * inv;
            float* R = (float*)(ws + WS_ROPE); R[2 * idx] = __cosf(ang); R[2 * idx + 1] = __sinf(ang);
        }
    }
}
__device__ __forceinline__ void prologue_b(KArgs a, int vcu, int G, int tid) {
    const float* P = (const float*)(a->ws + WS_MODP); float* Mo = (float*)(a->ws + WS_MOD);
    for (int i = vcu * 512 + tid; i < 4 * 5 * 9216 / 4; i += G * 512) {
        const int j4 = i % 2304, lm = i / 2304, l = lm / 5;
        f32x4 s = *(const f32x4*)(a->in[I_BMOD] + l * 9216 + j4 * 4);
#pragma unroll
        for (int kc = 0; kc < ADA_KC; ++kc) s += *(const f32x4*)(P + ((size_t)kc * 20 + lm) * 9216 + j4 * 4);
        *(f32x4*)(Mo + (size_t)lm * 9216 + j4 * 4) = s;
    }
}
template <bool XH> __device__ __forceinline__ void norm_phase(const float* x0, const float* x1, const float* g, const float* mod, int ish, int isc, bf16* H, _Float16* xcopy, int vcu, int G, int wave, int lane) {
    const int gw = vcu * NWAVES + wave, NGW = G * NWAVES;
    for (int m = gw; m < T; m += NGW) {
        const float* xr = (m < TC ? x0 : x1) + (size_t)m * D; const int ms = m < TC ? 0 : 1 + ((m - TC) >> 12);
        const float* sh = mod + (ms * 9 + ish) * 1024; const float* sc = mod + (ms * 9 + isc) * 1024;
        f32x4 v[4]; float s = 0.f;
#pragma unroll
        for (int j = 0; j < 4; ++j) { if (XH) { typedef _Float16 h4 __attribute__((ext_vector_type(4))); const h4 t = *(const h4*)((const _Float16*)x0 + (size_t)m * D + 4 * lane + 256 * j); v[j] = (f32x4){(float)t[0], (float)t[1], (float)t[2], (float)t[3]}; } else v[j] = *(const f32x4*)(xr + 4 * lane + 256 * j);
            s += (v[j].x * v[j].x + v[j].y * v[j].y) + (v[j].z * v[j].z + v[j].w * v[j].w); }
        const float rstd = 1.0f / sqrtf(wave_sum(s) * (1.f / D) + EPS);
        if (!XH && xcopy) {
#pragma unroll
            for (int j = 0; j < 4; ++j) { typedef _Float16 h4 __attribute__((ext_vector_type(4))); const h4 t = {(_Float16)v[j].x, (_Float16)v[j].y, (_Float16)v[j].z, (_Float16)v[j].w}; *(h4*)(xcopy + (size_t)m * D + 4 * lane + 256 * j) = t; } }
#pragma unroll
        for (int j = 0; j < 4; ++j) { const int c = 4 * lane + 256 * j; const f32x4 gg = *(const f32x4*)(g + c), a = *(const f32x4*)(sc + c), b = *(const f32x4*)(sh + c);
            const f32x4 y = (v[j] * rstd * gg) * (a + 1.0f) + b; v2u w; w.x = pk2(y[0], y[1]); w.y = pk2(y[2], y[3]); *(v2u*)(H + (size_t)m * D + c) = w; }
    }
}
__device__ __forceinline__ void final_norm(const float* x0, const float* g, float* out, int vcu, int G, int wave, int lane) {
    constexpr bool XH = true;
    const int gw = vcu * NWAVES + wave, NGW = G * NWAVES;
    for (int m = gw; m < T; m += NGW) {
        const float* xr = x0; f32x4 v[4]; float s = 0.f;
#pragma unroll
        for (int j = 0; j < 4; ++j) { if (XH) { typedef _Float16 h4 __attribute__((ext_vector_type(4))); const h4 t = *(const h4*)((const _Float16*)x0 + (size_t)m * D + 4 * lane + 256 * j); v[j] = (f32x4){(float)t[0], (float)t[1], (float)t[2], (float)t[3]}; } else v[j] = *(const f32x4*)(xr + 4 * lane + 256 * j);
            s += (v[j].x * v[j].x + v[j].y * v[j].y) + (v[j].z * v[j].z + v[j].w * v[j].w); }
        const float rstd = 1.0f / sqrtf(wave_sum(s) * (1.f / D) + EPS);
#pragma unroll
        for (int j = 0; j < 4; ++j) { const int c = 4 * lane + 256 * j; *(f32x4*)(out + (size_t)m * D + c) = v[j] * rstd * *(const f32x4*)(g + c); }
    }
}
__device__ __forceinline__ void pool_phase(const bf16* P, bf16* A2, int vcu, int G, int wave, int lane) {
    const int gw = vcu * NWAVES + wave, NGW = G * NWAVES; const int grp = lane >> 4, w = 2 << grp, wl = w >> 1, wh = w - 1 - wl;
    for (int m = gw; m < T; m += NGW) {
        int s0, L, p; if (m < TC) { s0 = m & ~255; L = 256; p = m - s0; } else { s0 = TC + ((m - TC) & ~4095); L = 4096; p = m - s0; }
        int lo = p - wl; lo = lo < 0 ? 0 : lo; int hi = p + wh; hi = hi > L - 1 ? L - 1 : hi;
        v4u x[16];
#pragma unroll
        for (int j = 0; j < 16; ++j) { int q = p - 8 + j; q = q < 0 ? 0 : q; q = q > L - 1 ? L - 1 : q; x[j] = *(const v4u*)(P + (size_t)(s0 + q) * 2048 + lane * 8); }
        float acc[8];
#pragma unroll
        for (int j = 0; j < 8; ++j) acc[j] = 0.f;
#pragma unroll
        for (int j = 0; j < 16; ++j) { const int q = p - 8 + j; const float wt = (q >= lo && q <= hi) ? 1.0f : 0.0f;
            acc[0] += wt * bf_lo(x[j].x); acc[1] += wt * bf_hi(x[j].x); acc[2] += wt * bf_lo(x[j].y); acc[3] += wt * bf_hi(x[j].y); acc[4] += wt * bf_lo(x[j].z); acc[5] += wt * bf_hi(x[j].z); acc[6] += wt * bf_lo(x[j].w); acc[7] += wt * bf_hi(x[j].w); }
        const float ic = 1.0f / (float)(hi - lo + 1);
        const v4u c = x[8];
        v4u o; o.x = pk2(acc[0] * ic - bf_lo(c.x), acc[1] * ic - bf_hi(c.x)); o.y = pk2(acc[2] * ic - bf_lo(c.y), acc[3] * ic - bf_hi(c.y));
        o.z = pk2(acc[4] * ic - bf_lo(c.z), acc[5] * ic - bf_hi(c.z)); o.w = pk2(acc[6] * ic - bf_lo(c.w), acc[7] * ic - bf_hi(c.w));
        *(v4u*)(A2 + (size_t)m * 1024 + lane * 8) = o;
    }
}
__device__ __forceinline__ void qk_post(bf16* P, const float* gq, const float* gk, const float* rope, bf16* Kcat, bf16* Vcat, float* kout, int vcu, int G, int wave, int lane) {
    const int gw = vcu * NWAVES + wave, NGW = G * NWAVES; const int sub = lane & 7, d0 = sub * 8;
    for (int m = gw; m < T; m += NGW) {
        const bool lat = m >= TC; const int tl = (m - TC) & 4095, bb = (m - TC) >> 12;
        const int pos = (sub & 4) ? (tl & 63) : (tl >> 6);
        const float* rp = rope + (pos * 16 + (sub & 1) * 8) * 2;
#pragma unroll
        for (int pass = 0; pass < 3; ++pass) {
            const int hh = pass * 8 + (lane >> 3);
            bf16* src = P + (size_t)m * 1536 + hh * 64 + d0;
            const v4u x = *(const v4u*)src;
            float e[8] = {bf_lo(x.x), bf_hi(x.x), bf_lo(x.y), bf_hi(x.y), bf_lo(x.z), bf_hi(x.z), bf_lo(x.w), bf_hi(x.w)};
            if (hh < 20) {
                float ss = 0.f;
#pragma unroll
                for (int j = 0; j < 8; ++j) ss += e[j] * e[j];
                ss += __shfl_xor(ss, 1); ss += __shfl_xor(ss, 2); ss += __shfl_xor(ss, 4);
                const float r = 1.0f / sqrtf(ss * (1.f / 64.f) + EPS); const float* gg = (hh < 16 ? gq : gk) + d0;
#pragma unroll
                for (int j = 0; j < 8; ++j) e[j] = e[j] * r * gg[j];
            }
            float pe[8];
#pragma unroll
            for (int j = 0; j < 8; ++j) pe[j] = __shfl_xor(e[j], 2);
            if (lat && hh < 20) {
                const float sgn = (sub & 2) ? 1.0f : -1.0f;
#pragma unroll
                for (int j = 0; j < 8; ++j) { const float c = rp[2 * j], s = rp[2 * j + 1]; e[j] = e[j] * c + sgn * pe[j] * s; }
            }
            if (hh < 16) {
#pragma unroll
                for (int j = 0; j < 8; ++j) e[j] *= attn_body::C2;
                v4u o; o.x = pk2(e[0], e[1]); o.y = pk2(e[2], e[3]); o.z = pk2(e[4], e[5]); o.w = pk2(e[6], e[7]); *(v4u*)src = o;
            } else if (hh < 20) {
                v4u o; o.x = pk2(e[0], e[1]); o.y = pk2(e[2], e[3]); o.z = pk2(e[4], e[5]); o.w = pk2(e[6], e[7]);
                if (lat) *(v4u*)(Kcat + ((size_t)bb * 4352 + 256 + tl) * 256 + (hh - 16) * 64 + d0) = o;
                else { *(v4u*)src = o; float* ko = kout + ((size_t)((m >> 8) * 2) * 256 + (m & 255)) * 256 + (hh - 16) * 64 + d0; *(f32x4*)ko = (f32x4){e[0], e[1], e[2], e[3]}; *(f32x4*)(ko + 4) = (f32x4){e[4], e[5], e[6], e[7]}; }
            } else if (lat) {
                *(v4u*)(Vcat + ((size_t)bb * 4352 + 256 + tl) * 256 + (hh - 20) * 64 + d0) = x;
            }
        }
    }
}
__device__ __forceinline__ void attn_even(const bf16* P, const bf16* CTX, bf16* A2, const float* rpb, char* lds, int vcu, int G) {
    typedef attn_body::bf16 ab;
    for (int u = vcu; u < 512 + 128; u += G) {
        attn_body::AttnUnitArgs A;
        if (u < 512) {
            const int b = u >> 7, h = (u >> 4) & 7, qb = u & 15; const size_t row0 = TC + (size_t)b * 4096;
            const int r0 = 4 * qb; int k0 = r0 - 4; k0 = k0 < 0 ? 0 : k0; k0 = k0 > 53 ? 53 : k0;
            A.Q = (const ab*)(P + (row0 + qb * 256) * 2048 + 512 + h * 64); A.qp = 2048;
            A.K0 = (const ab*)(CTX + (size_t)(b * 256) * 2048 + 1024 + h * 64); A.V0 = A.K0 + 512;
            A.K1 = (const ab*)(P + (row0 + k0 * 64) * 2048 + 1024 + h * 64); A.V1 = A.K1 + 512; A.kp = 2048; A.tsplit = 4; A.tmax = 10; A.NT = 16;
            A.O = (ab*)(A2 + (row0 + qb * 256) * 1024 + 512 + h * 64); A.op = 1024; A.r0 = r0; A.krow0 = k0; A.rpb = rpb + h * 465;
            attn_body::attn_unit<1, 8>(A, lds);
        } else {
            const int v = u - 512, b = v >> 3, h = v & 7; const size_t row0 = (size_t)b * 256;
            A.Q = (const ab*)(P + row0 * 2048 + 512 + h * 64); A.qp = 2048;
            A.K1 = (const ab*)(P + row0 * 2048 + 1024 + h * 64); A.V1 = A.K1 + 512; A.K0 = A.K1; A.V0 = A.V1; A.kp = 2048; A.tsplit = 0; A.tmax = 3; A.NT = 4;
            A.O = (ab*)(A2 + row0 * 1024 + 512 + h * 64); A.op = 1024; A.r0 = 0; A.krow0 = 0; A.rpb = rpb;
            attn_body::attn_unit<0, 8>(A, lds);
        }
    }
}
__device__ __forceinline__ void attn_odd(const bf16* P, const bf16* Kcat, const bf16* Vcat, bf16* A2, char* lds, int vcu, int G) {
    typedef attn_body::bf16 ab;
    for (int u = vcu; u < 1024 + 256; u += G) {
        attn_body::AttnUnitArgs A; A.tsplit = 0; A.r0 = 0; A.krow0 = 0; A.rpb = nullptr; A.qp = 1536; A.op = 1024;
        if (u < 1024) {
            const int b = u >> 8, kvh = (u >> 6) & 3, h4 = (u >> 4) & 3, qb = u & 15, hq = kvh * 4 + h4; const size_t row0 = TC + (size_t)b * 4096 + qb * 256;
            A.Q = (const ab*)(P + row0 * 1536 + hq * 64);
            A.K1 = (const ab*)(Kcat + (size_t)b * 4352 * 256 + kvh * 64); A.V1 = (const ab*)(Vcat + (size_t)b * 4352 * 256 + kvh * 64); A.kp = 256; A.tmax = 67; A.NT = 68;
            A.O = (ab*)(A2 + row0 * 1024 + hq * 64);
        } else {
            const int v = u - 1024, b = v >> 4, hq = v & 15, kvh = hq >> 2; const size_t row0 = (size_t)b * 256;
            A.Q = (const ab*)(P + row0 * 1536 + hq * 64);
            A.K1 = (const ab*)(P + row0 * 1536 + 1024 + kvh * 64); A.V1 = A.K1 + 256; A.kp = 1536; A.tmax = 3; A.NT = 4;
            A.O = (ab*)(A2 + row0 * 1024 + hq * 64);
        }
        A.K0 = A.K1; A.V0 = A.V1;
        attn_body::attn_unit<0, 8>(A, lds);
    }
}

#ifndef PH_LIMIT
#define PH_LIMIT 100000
#endif
#define PROBE_UP2 0
#define PROBE_SYNC2 0
#define PROBE_ATTN2 0
#define PROBE_NORM2 0
__global__ void __launch_bounds__(NWAVES * 64, 2) mega_fwd(Args args_unused) {
    extern __shared__ __attribute__((aligned(16))) unsigned char lds[];
    cg::grid_group grid = cg::this_grid();
    int nph = 0;
#define KA() ({ KArgs p_ = (KArgs)__builtin_amdgcn_kernarg_segment_ptr(); asm volatile("" : "+s"(p_)); p_; })
#define IDS() const int tid = tid_now(), lane = tid & 63, wave = __builtin_amdgcn_readfirstlane(tid >> 6); const int G = sgpr_now(gridDim.x), bx = sgpr_now(blockIdx.x), vcu = (G % 8 == 0) ? (bx % 8) * (G / 8) + bx / 8 : bx; (void)tid; (void)lane; (void)wave; (void)vcu
#define XBAR() do { XcdBarrier b_; b_.bar = (unsigned*)(KA()->ws + WS_CTL) + CW_BAR; b_.x = xb_xcc_id(); b_.st = (volatile LAS unsigned*)((LAS unsigned char*)lds + MISC_OFF) + 8; xcd_barrier(b_); } while (0)
#define SYNC() do { XBAR(); if (PROBE_SYNC2) XBAR(); if (++nph >= PH_LIMIT) return; } while (0)
    for (int u = threadIdx.x; u < (LDS_BYTES - LDSCTL_OFF) / 4; u += NWAVES * 64) ((LAS unsigned*)((LAS unsigned char*)lds + LDSCTL_OFF))[u] = 0u;
    __syncthreads();
    (void)xcd_barrier_post((unsigned*)(KA()->ws + WS_CTL) + CW_BAR, (volatile LAS unsigned*)((LAS unsigned char*)lds + MISC_OFF) + 8);

    { IDS(); prologue_a(KA(), (LAS unsigned char*)lds, vcu, G, wave, lane); }
    if (KA()->ws == nullptr) grid.sync();
    SYNC();
    { IDS(); prologue_b(KA(), vcu, G, tid); }
    SYNC();

#pragma unroll 1
    for (int ls = 0; ls < 12; ++ls) {
        const int l = ls / 3, sub = ls - 3 * l;
        const bool fusedn = (sgpr_now(gridDim.x) == 256);
        if (ls == 0 || !fusedn) {
            IDS(); KArgs a = KA(); unsigned char* ws = a->ws; const bool first = (ls == 0);
            const float* X = (const float*)(ws + WS_X);
            if (first) norm_phase<false>(a->in[I_XP], a->in[I_XS] - (size_t)TC * D, a->in[I_GNORM] + ls * 1024, (const float*)(ws + WS_MOD) + (size_t)l * 5 * 9216, 3 * sub, 3 * sub + 1, (bf16*)(ws + WS_H), (_Float16*)(ws + WS_X), vcu, G, wave, lane);
            else norm_phase<true>(X, X, a->in[I_GNORM] + ls * 1024, (const float*)(ws + WS_MOD) + (size_t)l * 5 * 9216, 3 * sub, 3 * sub + 1, (bf16*)(ws + WS_H), nullptr, vcu, G, wave, lane);
            SYNC();
        }
        if (sub != 1) {
            {
                KArgs a = KA(); unsigned char* ws = a->ws; const int mat = l * 2 + (sub >> 1);
                pg8::Gemm g{(const bf16*)(ws + WS_H), (const bf16*)(ws + WS_WFI) + (size_t)mat * NFF * 1024, T, NFF, D}; pg8::StaticOrder S; S.init(T, NFF, D, sgpr_now(gridDim.x), sgpr_now(blockIdx.x));
                pg8::EpiSwiGLU E{(bf16*)(ws + WS_U), DFF / FFO_KS, DFF / FFO_KS, (size_t)T * (DFF / FFO_KS)};
                pg8::gemm_phase<pg8::EpiSwiGLU, pg8::StaticOrder, true, true>((LAS unsigned char*)lds + RING_OFF, g, S, E);
                if (PROBE_UP2) { grid.sync(); pg8::gemm_phase<pg8::EpiSwiGLU, pg8::StaticOrder, true, true>((LAS unsigned char*)lds + RING_OFF, g, S, E); }
            }
            SYNC();
            {
                KArgs a = KA(); unsigned char* ws = a->ws; const int mat = l * 2 + (sub >> 1); const bool first = (ls == 0), last = (ls == 11);
                float* X = (float*)(ws + WS_X);
                pg8::Gemm g{(const bf16*)(ws + WS_U), (const bf16*)(ws + WS_WFO) + (size_t)mat * DFF * 1024, T, D, DFF}; pg8::TailOrder S; S.init(T, D, DFF, sgpr_now(gridDim.x), sgpr_now(blockIdx.x));
                pg8::EpiResid E{ws, last ? a->in[I_GFINAL] : a->in[I_GNORM], a->out, 0.5f, DFF / 64, ls, fusedn ? (last ? 2 : 1) : 0};
                pg8::gemm_phase<pg8::EpiResid, pg8::TailOrder, true, true>((LAS unsigned char*)lds + RING_OFF, g, S, E);
            }
            if (!(fusedn && ls == 11)) SYNC();
        } else {
            const int e = l >> 1; const bool even = !(l & 1);
            if (even) {
                KArgs a = KA(); unsigned char* ws = a->ws; float* out = a->out;
                float* o_nbk = out + (size_t)T * D, *o_nbv = o_nbk + 16 * 2 * 256 * 512;
                pg8::Gemm g{(const bf16*)(ws + WS_H), (const bf16*)(ws + WS_WIAB) + (size_t)e * 2048 * 1024, T, 2048, D}; pg8::StaticOrder S; S.init(T, 2048, D, sgpr_now(gridDim.x), sgpr_now(blockIdx.x));
                pg8::EpiProj E;
                E.O = (bf16*)(ws + WS_U); E.ldc = 2048; E.sc = attn_body::C2;
                E.sc_lo = 2; E.sc_hi = 4; E.fo[0] = o_nbk + (size_t)e * 256 * 512; E.f_lo[0] = 4; E.f_hi[0] = 6; E.fo[1] = o_nbv + (size_t)e * 256 * 512; E.f_lo[1] = 6; E.f_hi[1] = 8; E.fw = 512;
                pg8::gemm_phase<pg8::EpiProj, pg8::StaticOrder, true, true>((LAS unsigned char*)lds + RING_OFF, g, S, E);
            } else {
                KArgs a = KA(); unsigned char* ws = a->ws;
                pg8::Gemm g{(const bf16*)(ws + WS_H), (const bf16*)(ws + WS_WQKV) + (size_t)e * 1536 * 1024, T, 1536, D}; pg8::StaticOrder S; S.init(T, 1536, D, sgpr_now(gridDim.x), sgpr_now(blockIdx.x));
                pg8::EpiQKV E{ws, a->in[I_GQ] + e * 64, a->in[I_GK] + e * 64, a->out + (size_t)T * D + 2 * 16 * 2 * 256 * 512 + (size_t)e * 256 * 256, e};
                pg8::gemm_phase<pg8::EpiQKV, pg8::StaticOrder, true, true>((LAS unsigned char*)lds + RING_OFF, g, S, E);
            }
            SYNC();
            if (even) {
                { IDS(); KArgs a = KA(); unsigned char* ws = a->ws; pool_phase((const bf16*)(ws + WS_U), (bf16*)(ws + WS_A2), vcu, G, wave, lane); }
                { IDS(); KArgs a = KA(); unsigned char* ws = a->ws;
                  attn_even((const bf16*)(ws + WS_U), (const bf16*)(ws + WS_CTXNB) + (size_t)e * 1024 * 2048, (bf16*)(ws + WS_A2), a->in[I_RPB] + (size_t)e * 8 * 465, (char*)lds + RING_OFF, vcu, G); }
            } else {
                { IDS(); KArgs a = KA(); unsigned char* ws = a->ws;
                  attn_odd((const bf16*)(ws + WS_U), (const bf16*)(ws + WS_KCAT) + (size_t)e * KCAT_STRIDE, (const bf16*)(ws + WS_VCAT) + (size_t)e * KCAT_STRIDE, (bf16*)(ws + WS_A2), (char*)lds + RING_OFF, vcu, G); }
            }
            SYNC();
            {
                KArgs a = KA(); unsigned char* ws = a->ws; float* X = (float*)(ws + WS_X);
                pg8::Gemm g{(const bf16*)(ws + WS_A2), even ? (const bf16*)(ws + WS_WOAB) + (size_t)e * 1024 * 1024 : (const bf16*)(ws + WS_WOC) + (size_t)e * 1024 * 1024, T, D, D}; pg8::TailOrder S; S.init(T, D, D, sgpr_now(gridDim.x), sgpr_now(blockIdx.x));
                pg8::EpiResid E{ws, a->in[I_GNORM], a->out, 1.0f, D / 64, ls, fusedn ? 1 : 0};
                pg8::gemm_phase<pg8::EpiResid, pg8::TailOrder, true, true>((LAS unsigned char*)lds + RING_OFF, g, S, E);
            }
            SYNC();
        }
    }
    if (sgpr_now(gridDim.x) != 256) { IDS(); KArgs a = KA(); final_norm((const float*)(a->ws + WS_X), a->in[I_GFINAL], a->out, vcu, G, wave, lane); }
#undef SYNC
}

extern "C" void kernel_launch(void* const* d_in, const int* in_sizes, int n_in, void* d_out, int out_size, void* d_ws, size_t ws_size, hipStream_t stream) {
    static int grid = 0;
    if (grid == 0) {
        if (n_in != 23 || ws_size < WS_END || out_size != 33554432) { fprintf(stderr, "kernel_launch: unexpected shapes: n_in %d out %d ws %zu (need %zu)\n", n_in, out_size, ws_size, (size_t)WS_END); grid = -1; return; }
        int dev = 0, cus = 0, per_cu = 0;
        if (hipGetDevice(&dev) != hipSuccess || hipDeviceGetAttribute(&cus, hipDeviceAttributeMultiprocessorCount, dev) != hipSuccess) { grid = -1; return; }
        if (hipFuncSetAttribute((const void*)mega_fwd, hipFuncAttributeMaxDynamicSharedMemorySize, LDS_BYTES) != hipSuccess) { fprintf(stderr, "kernel_launch: hipFuncSetAttribute failed\n"); grid = -1; return; }
        if (hipOccupancyMaxActiveBlocksPerMultiprocessor(&per_cu, (const void*)mega_fwd, NWAVES * 64, LDS_BYTES) != hipSuccess || per_cu < 1) { fprintf(stderr, "kernel_launch: occupancy query says %d\n", per_cu); per_cu = 1; }
        (void)hipGetLastError();
        grid = cus * per_cu;
    }
    if (grid < 0) return;
    if (hipMemsetAsync((char*)d_ws + WS_CTL, 0, CTL_ZERO_BYTES, stream) != hipSuccess) { fprintf(stderr, "kernel_launch: memset of the barrier words failed\n"); return; }
    Args a{};
    for (int i = 0; i < 23; ++i) a.in[i] = (const float*)d_in[i];
    a.out = (float*)d_out; a.ws = (unsigned char*)d_ws;
    void* params[] = {&a};
    const hipError_t le = hipLaunchCooperativeKernel((const void*)mega_fwd, dim3(grid), dim3(NWAVES * 64), params, LDS_BYTES, stream);
    if (le != hipSuccess) fprintf(stderr, "kernel_launch: cooperative launch failed: %s (grid %d)\n", hipGetErrorName(le), grid);
}
```
